# Optimizing an MI355X kernel written in HIP

```python
import jax, jax.numpy as jnp
from jax import lax
import numpy as np

D_MODEL = 1024
BATCH = 4
SEQ = 8192
DEPTH = 4

CHUNK = 64
CONV_W = 512
CONV_K = 31
SGU_W = 512
SGU_GROUPS = 4
SGU_CHUNK = 128
ATTN_HEADS = 8
ATTN_HEAD_DIM = 64
ATTN_W = ATTN_HEADS * ATTN_HEAD_DIM
ATTN_LEFT_CHUNKS = 8
ATTN_BAND = (ATTN_LEFT_CHUNKS + 1) * CHUNK
REL_MIN = -(CHUNK - 1)
REL_MAX = 128
N_REL = REL_MAX - REL_MIN + 1
N_BRANCH = 3
N_IN = 2 * CONV_W + 2 * SGU_W + 3 * ATTN_W + N_BRANCH * D_MODEL
D_FF = 2816
N_EXPERTS = 8
TOP_K = 2
D_FF_EXPERT = 3584
N_DENSE = (DEPTH + 1) // 2
N_MOE = DEPTH // 2
EPS = 1e-6
NEG_INF = -1e30

kernel_name = "hybrid_conv_sgu_chunkattn_moe_trunk"


def rms_norm(x, g):
    xf = x.astype(jnp.float32)
    y = xf * lax.rsqrt(jnp.mean(xf * xf, axis=-1, keepdims=True) + EPS)
    return (y * g.astype(jnp.float32)).astype(x.dtype)


def layer_norm(x, g, b):
    xf = x.astype(jnp.float32)
    mu = jnp.mean(xf, axis=-1, keepdims=True)
    var = jnp.mean(jnp.square(xf - mu), axis=-1, keepdims=True)
    y = (xf - mu) * lax.rsqrt(var + EPS) * g.astype(jnp.float32) + b.astype(jnp.float32)
    return y.astype(x.dtype)


def conv_branch(a, dw_w, dw_b, ln_g, ln_b, out_w):
    h = a[..., :CONV_W] * jax.nn.sigmoid(a[..., CONV_W:])
    h = lax.conv_general_dilated(
        h, dw_w[:, None, :], window_strides=(1,), padding=[(CONV_K - 1, 0)],
        dimension_numbers=("NWC", "WIO", "NWC"), feature_group_count=CONV_W) + dw_b
    h = jax.nn.silu(layer_norm(h, ln_g, ln_b))
    return h @ out_w


def sgu_branch(a, ws, bs, ln_g, ln_b, out_w):
    b, s, _ = a.shape
    a = jax.nn.gelu(a, approximate=False)
    u, v = a[..., :SGU_W], a[..., SGU_W:]
    v = layer_norm(v, ln_g, ln_b)
    n = s // SGU_CHUNK
    v = v.reshape(b, n, SGU_CHUNK, SGU_GROUPS, SGU_W // SGU_GROUPS)
    pos = jnp.arange(SGU_CHUNK)
    mask = (pos[None, :] // CHUNK) <= (pos[:, None] // CHUNK)
    w = jnp.where(mask[None], ws, jnp.zeros_like(ws))
    mixed = jnp.einsum("gts,bnsgc->bntgc", w, v) + bs.T[:, :, None]
    return (u * mixed.reshape(b, s, SGU_W)) @ out_w


def attn_branch(a, rel_table, out_w):
    b, s, _ = a.shape
    nc = s // CHUNK
    shp = (b, nc, CHUNK, ATTN_HEADS, ATTN_HEAD_DIM)
    q = a[..., :ATTN_W].reshape(shp)
    k = a[..., ATTN_W:2 * ATTN_W].reshape(shp)
    v = a[..., 2 * ATTN_W:].reshape(shp)
    pad = ((0, 0), (ATTN_LEFT_CHUNKS, 0), (0, 0), (0, 0), (0, 0))
    kp, vp = jnp.pad(k, pad), jnp.pad(v, pad)
    k_band = jnp.concatenate([kp[:, j:j + nc] for j in range(ATTN_LEFT_CHUNKS + 1)], axis=2)
    v_band = jnp.concatenate([vp[:, j:j + nc] for j in range(ATTN_LEFT_CHUNKS + 1)], axis=2)
    scores = jnp.einsum("bnqhd,bnkhd->bnhqk", q, k_band,
                        preferred_element_type=jnp.float32) * (ATTN_HEAD_DIM ** -0.5)
    qi = jnp.arange(CHUNK)
    kj = jnp.arange(ATTN_BAND)
    rel = ATTN_LEFT_CHUNKS * CHUNK + qi[:, None] - kj[None, :]
    idx = jnp.clip(rel, REL_MIN, REL_MAX) - REL_MIN
    bias = rel_table.astype(jnp.float32)[:, idx]
    key_chunk = jnp.arange(nc)[:, None] - ATTN_LEFT_CHUNKS + kj[None, :] // CHUNK
    valid = key_chunk >= 0
    add = jnp.where(valid[:, None, None, :], bias[None], NEG_INF)
    p = jax.nn.softmax(scores + add[None], axis=-1).astype(v.dtype)
    o = jnp.einsum("bnhqk,bnkhd->bnqhd", p, v_band)
    return o.reshape(b, s, ATTN_W) @ out_w


def swiglu(x, wg, wu, wd):
    return (jax.nn.silu(x @ wg) * (x @ wu)) @ wd


def moe_swiglu(x, router, wg, wu, wd):
    b, s, d = x.shape
    t = x.reshape(b * s, d)
    logits = jnp.dot(t, router, preferred_element_type=jnp.float32)
    top_v, top_i = lax.top_k(logits, TOP_K)
    top_w = jax.nn.softmax(top_v, axis=-1)
    combine = jnp.sum(jax.nn.one_hot(top_i, N_EXPERTS, dtype=jnp.float32) * top_w[..., None], axis=1)
    combine = combine.astype(t.dtype)
    out = jnp.zeros_like(t)
    for e in range(N_EXPERTS):
        out = out + combine[:, e:e + 1] * swiglu(t, wg[e], wu[e], wd[e])
    return out.reshape(b, s, d)


def setup_inputs(seed: int = 0) -> dict:
    key = jax.random.key(seed)
    ks = iter(jax.random.split(key, 32))

    def nrm(shape, scale):
        return jax.random.normal(next(ks), shape, jnp.float32) * scale

    L, D = DEPTH, D_MODEL
    return {
        "x": nrm((BATCH, SEQ, D), 1.0),
        "mix_norm_g": 1.0 + nrm((L, D), 0.02),
        "w_in": nrm((L, D, N_IN), D ** -0.5),
        "b_gate": nrm((L, N_BRANCH * D), 0.02),
        "conv_dw_w": nrm((L, CONV_K, CONV_W), CONV_K ** -0.5),
        "conv_dw_b": nrm((L, CONV_W), 0.02),
        "conv_ln_g": 1.0 + nrm((L, CONV_W), 0.02),
        "conv_ln_b": nrm((L, CONV_W), 0.02),
        "conv_out_w": nrm((L, CONV_W, D), CONV_W ** -0.5),
        "sgu_ln_g": 1.0 + nrm((L, SGU_W), 0.02),
        "sgu_ln_b": nrm((L, SGU_W), 0.02),
        "sgu_ws": nrm((L, SGU_GROUPS, SGU_CHUNK, SGU_CHUNK), SGU_CHUNK ** -0.5),
        "sgu_bs": 1.0 + nrm((L, SGU_GROUPS, SGU_CHUNK), 0.02),
        "sgu_out_w": nrm((L, SGU_W, D), SGU_W ** -0.5),
        "attn_rel_bias": nrm((L, ATTN_HEADS, N_REL), 0.1),
        "attn_out_w": nrm((L, ATTN_W, D), ATTN_W ** -0.5),
        "w_out": nrm((L, D, D), D ** -0.5),
        "ffn_norm_g": 1.0 + nrm((L, D), 0.02),
        "ffn_w_gate": nrm((N_DENSE, D, D_FF), D ** -0.5),
        "ffn_w_up": nrm((N_DENSE, D, D_FF), D ** -0.5),
        "ffn_w_down": nrm((N_DENSE, D_FF, D), D_FF ** -0.5),
        "moe_router": nrm((N_MOE, D, N_EXPERTS), D ** -0.5),
        "moe_w_gate": nrm((N_MOE, N_EXPERTS, D, D_FF_EXPERT), D ** -0.5),
        "moe_w_up": nrm((N_MOE, N_EXPERTS, D, D_FF_EXPERT), D ** -0.5),
        "moe_w_down": nrm((N_MOE, N_EXPERTS, D_FF_EXPERT, D), D_FF_EXPERT ** -0.5),
        "final_norm_g": 1.0 + nrm((D,), 0.02),
    }


def reference(x, mix_norm_g, w_in, b_gate, conv_dw_w, conv_dw_b, conv_ln_g, conv_ln_b,
              conv_out_w, sgu_ln_g, sgu_ln_b, sgu_ws, sgu_bs, sgu_out_w, attn_rel_bias,
              attn_out_w, w_out, ffn_norm_g, ffn_w_gate, ffn_w_up, ffn_w_down, moe_router,
              moe_w_gate, moe_w_up, moe_w_down, final_norm_g):
    o1 = 2 * CONV_W
    o2 = o1 + 2 * SGU_W
    o3 = o2 + 3 * ATTN_W
    h = x
    for layer in range(DEPTH):
        xn = rms_norm(h, mix_norm_g[layer])
        a = xn @ w_in[layer]
        y_conv = conv_branch(a[..., :o1], conv_dw_w[layer], conv_dw_b[layer],
                             conv_ln_g[layer], conv_ln_b[layer], conv_out_w[layer])
        y_sgu = sgu_branch(a[..., o1:o2], sgu_ws[layer], sgu_bs[layer],
                           sgu_ln_g[layer], sgu_ln_b[layer], sgu_out_w[layer])
        y_attn = attn_branch(a[..., o2:o3], attn_rel_bias[layer], attn_out_w[layer])
        g = jax.nn.sigmoid(a[..., o3:] + b_gate[layer])
        merged = (g[..., :D_MODEL] * y_conv
                  + g[..., D_MODEL:2 * D_MODEL] * y_sgu
                  + g[..., 2 * D_MODEL:] * y_attn)
        h = h + merged @ w_out[layer]
        xn = rms_norm(h, ffn_norm_g[layer])
        i = layer // 2
        if layer % 2 == 0:
            h = h + swiglu(xn, ffn_w_gate[i], ffn_w_up[i], ffn_w_down[i])
        else:
            h = h + moe_swiglu(xn, moe_router[i], moe_w_gate[i], moe_w_up[i], moe_w_down[i])
    return rms_norm(h, final_norm_g)
```

```cpp
#include <hip/hip_runtime.h>
#include <hip/hip_bf16.h>
#include <cmath>
#include <cstdio>
#include <cstdint>

#ifndef MK_MULTI
#define MK_MULTI 0
#endif

#ifndef PROBE
#define PROBE 0
#endif
#ifndef PHMASK
#define PHMASK 0xFFFFFFFFu
#endif
#define PHM(b) ((PHMASK >> (b)) & 1u)
#define LAS __attribute__((address_space(3)))
#define GAS __attribute__((address_space(1)))
typedef unsigned short bf16;
typedef short bf16x8 __attribute__((ext_vector_type(8)));
typedef short s16x4 __attribute__((ext_vector_type(4)));
typedef float f32x4 __attribute__((ext_vector_type(4)));
typedef float f32x2 __attribute__((ext_vector_type(2)));
typedef unsigned u32x4 __attribute__((ext_vector_type(4)));
typedef unsigned u32x2 __attribute__((ext_vector_type(2)));
typedef int i32x4 __attribute__((ext_vector_type(4)));
typedef int i32x8 __attribute__((ext_vector_type(8)));

constexpr int DM = 1024, NBATCH = 4, SEQ = 8192, NTOK = NBATCH * SEQ, DEPTH = 4;
constexpr int NIN = 6656;
constexpr int LDA = 5120;
constexpr int A_CONV = 0, A_SGU = 1024, A_Q = 2048, A_K = 2560, A_HC = 3072, A_G = 3584, A_V = 4608;
constexpr int A8_HC = A_HC * 2, A8_SGU = (A_SGU + 512) * 2, A8_ATT = 1024;
constexpr int G_COL0 = 3072, NGATE = 3072;
constexpr int NMAIN = 6656;
constexpr int DFF = 2816, NEXP = 8, DFE = 3584;
constexpr int MAXSLOT = 67584;
constexpr float EPS = 1e-6f;
constexpr float LOG2E = 1.4426950408889634f;
constexpr int F8_WIN_FROM = 2;
constexpr int MOE1_TAIL_EXPERTS = 3, TAIL_WG0 = 32;
constexpr bool SPLIT_FINAL = true;
constexpr int F8_BR_FROM = 2;
constexpr int I8_WOUT_FROM = 0;
constexpr float I8_SXM = 32.0f;
constexpr int F8_WOUT_FROM = 2;
static_assert(F8_BR_FROM >= F8_WOUT_FROM, "an fp8 branch GEMM writes merged through the e4m3 path of the branch epilogue");
constexpr int F8_GATE_FROM = 0;
static_assert(F8_GATE_FROM >= 0 && F8_GATE_FROM <= 2, "the e4m3 gate weights of layers 0 / 1 live in the free halves of layer 2's / 3's w_in slots");
static_assert(F8_WIN_FROM == 2, "the combine phase of layer 1 writes the e4m3 operand of layer 2's w_in");
constexpr int F8_DENSE_LAYER = 2;
constexpr bool I8_WIN_ALL = true, I8_UP = true, I8_UP_L0 = false;
constexpr bool I8_WIN = true;
constexpr float I8_SXU0 = 16.0f, I8_SXU2 = 13.0f;
__host__ __device__ constexpr float i8_sxu(int producer_layer) { return producer_layer == 0 ? I8_SXU0 : I8_SXU2; }
constexpr float I8_SXN = 24.0f, I8_SXU = 10.0f, I8_SW = 800.0f;
constexpr float F8_SX = 8.0f, F8_SW = 64.0f, F8_SI = 8.0f;

constexpr size_t MiB = 1u << 20;
constexpr size_t WS_CTL = 0, CTL_ZERO_BYTES = 65536;
constexpr size_t WS_ROUTE = 1 * MiB;
constexpr size_t WS_WIN = 2 * MiB;
constexpr size_t WS_WG8 = WS_WIN + (size_t)2 * 6656 * 1024 * 2 + (size_t)6656 * 1024;
constexpr size_t WS_WG8_STEP = (size_t)6656 * 1024 * 2;
constexpr size_t WS_WBR = 54 * MiB;
constexpr size_t WS_WO = 66 * MiB;
constexpr size_t WS_SGUW = 74 * MiB;
constexpr size_t WS_FGU = 75 * MiB;
constexpr size_t WS_FD = 97 * MiB;
constexpr size_t WS_MGU = 108 * MiB;
constexpr size_t WS_MD = 220 * MiB;
constexpr size_t WS_XN = 276 * MiB;
constexpr size_t WS_BIG = 340 * MiB;
constexpr size_t WS_G8 = WS_BIG + 320 * MiB;
constexpr size_t WS_XF8 = WS_BIG + 416 * MiB;
constexpr size_t WS_Y = 802 * MiB;
constexpr size_t WS_PART = 934 * MiB;
constexpr size_t WS_END = 936 * MiB;
constexpr int CW_BAR = 4096;
constexpr int CW_CNT = 8192;
constexpr int CW_ARR = 9216;
constexpr int CW_P7A = 9344;
constexpr int CW_TAB = 10240;

constexpr int ATTN_TAB_OFF = 133120;
constexpr int LDS_BIAS_OFF = 131072;
constexpr int LDS_SCRATCH = 143360;
constexpr int LDSCTL_OFF = LDS_SCRATCH;
constexpr int LDS_ROWSCALE_OFF = 147456;
constexpr int LDS_BYTES = 155648;

__device__ __forceinline__ unsigned cvt_pk_bf16(float lo, float hi) { unsigned r; asm volatile("v_cvt_pk_bf16_f32 %0, %1, %2" : "=v"(r) : "v"(lo), "v"(hi)); return r; }
__device__ __forceinline__ float clamp448(float v) { return __builtin_amdgcn_fmed3f(v, -448.0f, 448.0f); }
__device__ __forceinline__ unsigned cvt4_fp8(float a, float b, float c, float d) { int p = __builtin_amdgcn_cvt_pk_fp8_f32(clamp448(a), clamp448(b), 0, false); p = __builtin_amdgcn_cvt_pk_fp8_f32(clamp448(c), clamp448(d), p, true); return (unsigned)p; }
__device__ __forceinline__ unsigned cvt4_i8(float a, float b, float c, float d) {
    const float M = 12582912.0f;
    const unsigned ua = __float_as_uint(__builtin_amdgcn_fmed3f(a, -127.0f, 127.0f) + M), ub = __float_as_uint(__builtin_amdgcn_fmed3f(b, -127.0f, 127.0f) + M);
    const unsigned uc = __float_as_uint(__builtin_amdgcn_fmed3f(c, -127.0f, 127.0f) + M), ud = __float_as_uint(__builtin_amdgcn_fmed3f(d, -127.0f, 127.0f) + M);
    return __builtin_amdgcn_perm(ub, ua, 0x0c0c0400u) | __builtin_amdgcn_perm(ud, uc, 0x04000c0cu);
}
__device__ __forceinline__ float bflo(unsigned p) { return __uint_as_float(p << 16); }
__device__ __forceinline__ float bfhi(unsigned p) { return __uint_as_float(p & 0xffff0000u); }
__device__ __forceinline__ float fast_sigmoid(float x) { return __builtin_amdgcn_rcpf(1.0f + __builtin_amdgcn_exp2f(-x * LOG2E)); }
template <int CTRL, int ROWMASK> __device__ __forceinline__ float dpp_f(float v) { return __builtin_bit_cast(float, __builtin_amdgcn_update_dpp(0, __builtin_bit_cast(int, v), CTRL, ROWMASK, 0xF, false)); }
__device__ __forceinline__ float wave_sum(float v) {
    v += dpp_f<0xB1, 0xF>(v); v += dpp_f<0x4E, 0xF>(v); v += dpp_f<0x141, 0xF>(v); v += dpp_f<0x140, 0xF>(v);
    v += dpp_f<0x142, 0xA>(v); v += dpp_f<0x143, 0xC>(v);
    return __builtin_bit_cast(float, __builtin_amdgcn_readlane(__builtin_bit_cast(int, v), 63));
}
__device__ __forceinline__ f32x2 gelu_pk(f32x2 v) {
    const f32x2 av = __builtin_elementwise_abs(v), d = av * 0.2316418882f + 1.0f;
    f32x2 t; t.x = __builtin_amdgcn_rcpf(d.x); t.y = __builtin_amdgcn_rcpf(d.y);
    f32x2 q = t * 0.5307027145f + (-0.7265760135f); q = q * t + 0.7107068705f; q = q * t + (-0.142248368f); q = q * t + 0.127414796f; q = q * t;
    const f32x2 s = (v * v) * (-0.72134752044f);
    f32x2 e; e.x = __builtin_amdgcn_exp2f(s.x); e.y = __builtin_amdgcn_exp2f(s.y);
    const f32x2 m = v * (q * e), r = v - m;
    f32x2 o; o.x = v.x < 0.f ? m.x : r.x; o.y = v.y < 0.f ? m.y : r.y; return o;
}

#define XB_TMO      128
#define XB_XCNT(j)  (256  + 64 * (j))
#define XB_XSUB(j)  (1280 + 64 * (j))
#define XB_XGEN(j)  (2304 + 64 * (j))
#define XB_TOP      3328
#define XB_TOPGEN   3392
#define XCD_BAR_WORDS 3456
#define XB_SPIN_CAP (1u << 18)
__device__ __forceinline__ unsigned xb_ld(unsigned* p)              { return __hip_atomic_load(p, __ATOMIC_RELAXED, __HIP_MEMORY_SCOPE_AGENT); }
__device__ __forceinline__ unsigned xb_add(unsigned* p, unsigned v) { return __hip_atomic_fetch_add(p, v, __ATOMIC_RELAXED, __HIP_MEMORY_SCOPE_AGENT); }
__device__ __forceinline__ unsigned xb_xcc_id() { return (unsigned)__builtin_amdgcn_s_getreg((3 << 11) | 20) & 0xFu; }
#define XB_SPIN(cond, bar) do { unsigned _sp = 0; while (cond) { __builtin_amdgcn_s_sleep(1); \
    if ((++_sp & 255u) == 0u) { if (xb_ld(&(bar)[XB_TMO])) break; if (_sp > XB_SPIN_CAP) { atomicAdd(&(bar)[XB_TMO], 1u); break; } } } } while (0)
struct XcdBarrier { unsigned* bar; unsigned x; volatile LAS unsigned* st; };
__device__ __forceinline__ XcdBarrier xcd_barrier_post(unsigned* bar, volatile LAS unsigned* st) {
    XcdBarrier b; b.bar = bar; b.x = xb_xcc_id(); b.st = st;
    if (threadIdx.x == 0) (void)xb_add(&bar[XB_XCNT(b.x)], 1u);
    return b;
}
__device__ __forceinline__ void xcd_barrier_complete(unsigned* bar, unsigned x, unsigned& nloc, unsigned& nx) {
    const unsigned G = gridDim.x * gridDim.y * gridDim.z;
    unsigned sum, cnt, mine, sp = 0u;
    for (;;) {
        sum = 0u; cnt = 0u; mine = 0u;
#pragma unroll
        for (unsigned j = 0; j < 16; ++j) { const unsigned c = xb_ld(&bar[XB_XCNT(j)]); sum += c; cnt += (c > 0u) ? 1u : 0u; mine = (j == x) ? c : mine; }
        if (sum == G) break;
        __builtin_amdgcn_s_sleep(1);
        if ((++sp & 255u) == 0u) { if (xb_ld(&bar[XB_TMO])) break; if (sp > XB_SPIN_CAP) { atomicAdd(&bar[XB_TMO], 1u); break; } }
    }
    nloc = mine > 0u ? mine : 1u; nx = cnt > 0u ? cnt : 1u;
}
__device__ __forceinline__ void xcd_barrier(const XcdBarrier& b) {
    asm volatile("s_waitcnt vmcnt(0)" ::: "memory");
    __syncthreads();
    if (threadIdx.x == 0) {
        unsigned* bar = b.bar;
        __builtin_amdgcn_s_waitcnt(0);
        unsigned nloc = b.st[0], nx = b.st[1];
        if (nloc == 0u) { xcd_barrier_complete(bar, b.x, nloc, nx); b.st[0] = nloc; b.st[1] = nx; }
        const unsigned old = xb_add(&bar[XB_XSUB(b.x)], 1u);
        const unsigned gen = old / nloc;
        if (old + 1u == (gen + 1u) * nloc) {
            __builtin_amdgcn_fence(__ATOMIC_RELEASE, "agent");
            asm volatile("s_waitcnt vmcnt(0)" ::: "memory");
            const unsigned og = xb_add(&bar[XB_TOP], 1u);
            const unsigned tg = og / nx;
            if (og + 1u == (tg + 1u) * nx) xb_add(&bar[XB_TOPGEN], 1u);
            else XB_SPIN(xb_ld(&bar[XB_TOPGEN]) == tg, bar);
            __builtin_amdgcn_fence(__ATOMIC_ACQUIRE, "agent");
            xb_add(&bar[XB_XGEN(b.x)], 1u);
            asm volatile("s_waitcnt vmcnt(0)" ::: "memory");
        } else {
            XB_SPIN(xb_ld(&bar[XB_XGEN(b.x)]) == gen, bar);
            __builtin_amdgcn_fence(__ATOMIC_ACQUIRE, "agent");
            asm volatile("s_waitcnt vmcnt(0)" ::: "memory");
        }
    }
    __syncthreads();
}

namespace pg8 {
constexpr int BM = 256, BK = 64, HALF = 128, HTB = HALF * BK * 2, STAGE_BYTES = 8 * HTB, NXCD = 8, WGM = 8;
__device__ __forceinline__ int lds_byte(int r, int c) { const int st = (r >> 4) * 2 + (c >> 5), rr = r & 15, cc = c & 31, ob = rr * 64 + cc * 2; return st * 1024 + (ob ^ (((ob >> 9) & 1) << 5)); }
__device__ __forceinline__ void stage_rc(int b, int& R, int& C) { const int st = b / 1024, sb = b % 1024, swz = sb ^ (((sb >> 9) & 1) << 5); R = (st >> 1) * 16 + swz / 64; C = (st & 1) * 32 + (swz % 64) / 2; }
__device__ __forceinline__ int perm32(int rho) { const int n = rho >> 4, i = rho & 15; return 8 * (i >> 2) + 4 * n + (i & 3); }

struct Unit { int pm, pn, kind; const char* A; const char* B; };

struct TileOrder {
    int nM, nN, nwg, G, c;
    __device__ __forceinline__ void init(int nM_, int nN_, int G_, int c_) { nM = nM_; nN = nN_; nwg = nM * nN; G = G_; c = c_; }
    __device__ __forceinline__ bool tile(int i, int& pm, int& pn) const {
        const long L = (long)i * G + c; if (L >= nwg) return false;
        int wgid = (int)L; { const int q = nwg / NXCD, r = nwg % NXCD, xcd = wgid % NXCD, off = wgid / NXCD; wgid = (xcd < r ? xcd * (q + 1) : r * (q + 1) + (xcd - r) * q) + off; }
        const int nig = WGM * nN, gid = wgid / nig, fm = gid * WGM, gsz = (nM - fm) < WGM ? (nM - fm) : WGM;
        pm = fm + ((wgid % nig) % gsz); pn = (wgid % nig) / gsz; return true;
    }
};

__device__ __forceinline__ const char* uniform_ptr(const char* p) { const unsigned long long v = (unsigned long long)p;
    const unsigned lo = __builtin_amdgcn_readfirstlane((unsigned)v), hi = __builtin_amdgcn_readfirstlane((unsigned)(v >> 32)); return (const char*)(((unsigned long long)hi << 32) | lo); }
__device__ __forceinline__ void glds16(const char* sbase, unsigned voff, unsigned ldsaddr) {
    unsigned keep;
    asm volatile("s_mov_b32 %0, m0\n\ts_mov_b32 m0, %3\n\ts_nop 0\n\tglobal_load_lds_dwordx4 %1, %2\n\ts_mov_b32 m0, %0"
                 : "=&s"(keep) : "v"(voff), "s"(sbase), "s"(ldsaddr) : "memory");
}
__device__ __forceinline__ void mfma_f8_inplace(f32x4& c, const i32x8 a, const i32x8 b, const unsigned sc) {
    asm volatile("v_mfma_scale_f32_16x16x128_f8f6f4 %0, %1, %2, %0, %3, %3 op_sel_hi:[0,0,0]" : "+v"(c) : "v"(a), "v"(b), "v"(sc));
}
template <class Epi, class Sched, bool FP8 = false, bool I8 = false>
__device__ __forceinline__ void gemm_phase(LAS unsigned char* lds, const int K, const unsigned lda2, const unsigned ldb2, const Sched& S, const Epi& E) {
    int tid_ = threadIdx.x; asm volatile("" : "+v"(tid_));
    const int tid = tid_, wid = __builtin_amdgcn_readfirstlane(tid >> 6), lane = tid & 63, wr = wid >> 2, wc = wid & 3, fr = lane & 15, fq = lane >> 4;
    int nt_ = K / BK; asm volatile("" : "+s"(nt_)); const int nt = nt_;
    unsigned voffA[2], voffB[2];
#pragma unroll
    for (int i = 0; i < 2; ++i) { int R, C; stage_rc(tid * 16 + i * 8192, R, C); const int Rb = Epi::PERM ? ((R & ~31) + perm32(R & 31)) : R;
        voffA[i] = (unsigned)R * lda2 + (unsigned)C * 2u; voffB[i] = (unsigned)Rb * ldb2 + (unsigned)C * 2u; }
    const size_t kstep = (size_t)(BK * 2);
    const size_t hstepA = (size_t)HALF * lda2, hstepB = (size_t)HALF * ldb2;
    const unsigned ldsw = (unsigned)wid * 1024u;
    const unsigned lds0 = (unsigned)(size_t)lds;
    const int aoff = lds_byte(wr * 64 + fr, fq * 8), boff = lds_byte(wc * 32 + fr, fq * 8);
#define PG8_SA(b, h) (((b) * 2 + (h)) * HTB)
#define PG8_SB(b, h) ((4 + (b) * 2 + (h)) * HTB)
#define PG8_STAGE(bufoff, gbase, voff) do { const char* _gb = (const char*)(gbase); const unsigned _la = lds0 + (unsigned)(bufoff) + ldsw; \
        glds16(_gb, (voff)[0], _la); glds16(_gb, (voff)[1], _la + 8192u); } while (0)
#define PG8_LDA(dst, b, h) do { _Pragma("unroll") for (int m = 0; m < 4; ++m) _Pragma("unroll") for (int k = 0; k < 2; ++k) dst[m][k] = *(const LAS bf16x8*)(lds + PG8_SA(b, h) + aoff + m * 2048 + k * 1024); } while (0)
#define PG8_LDB(dst, b, h) do { _Pragma("unroll") for (int n = 0; n < 2; ++n) _Pragma("unroll") for (int k = 0; k < 2; ++k) dst[n][k] = *(const LAS bf16x8*)(lds + PG8_SB(b, h) + boff + n * 2048 + k * 1024); } while (0)
#define PG8_CAT(x) __builtin_shufflevector(__builtin_bit_cast(i32x4, (x)[0]), __builtin_bit_cast(i32x4, (x)[1]), 0, 1, 2, 3, 4, 5, 6, 7)
#define PG8_MMA(ai, bj, At, Bt) do { __builtin_amdgcn_s_setprio(1); \
        if constexpr (FP8) { _Pragma("unroll") for (int m = 0; m < 4; ++m) _Pragma("unroll") for (int n = 0; n < 2; ++n) \
            mfma_f8_inplace(acc[ai][bj][m][n], PG8_CAT(Bt[n]), PG8_CAT(At[m]), f8scale); } \
        else if constexpr (I8) { _Pragma("unroll") for (int m = 0; m < 4; ++m) _Pragma("unroll") for (int n = 0; n < 2; ++n) _Pragma("unroll") for (int k = 0; k < 2; ++k) \
            acc[ai][bj][m][n] = __builtin_bit_cast(f32x4, __builtin_amdgcn_mfma_i32_16x16x64_i8(__builtin_bit_cast(i32x4, Bt[n][k]), __builtin_bit_cast(i32x4, At[m][k]), __builtin_bit_cast(i32x4, acc[ai][bj][m][n]), 0, 0, 0)); } \
        else { _Pragma("unroll") for (int m = 0; m < 4; ++m) _Pragma("unroll") for (int n = 0; n < 2; ++n) _Pragma("unroll") for (int k = 0; k < 2; ++k) \
            acc[ai][bj][m][n] = __builtin_amdgcn_mfma_f32_16x16x32_bf16(Bt[n][k], At[m][k], acc[ai][bj][m][n], 0, 0, 0); } \
        __builtin_amdgcn_s_setprio(0); } while (0)
#define PG8_WAIT_V(n) asm volatile("s_waitcnt vmcnt(" #n ")" ::: "memory")
#define PG8_WAIT_L(n) asm volatile("s_waitcnt lgkmcnt(" #n ")" ::: "memory")
#define PG8_BAR __builtin_amdgcn_s_barrier()
#define PG8_SCHED __builtin_amdgcn_sched_barrier(0)
    unsigned f8scale = 0x7f7f7f7fu; asm volatile("" : "+v"(f8scale));
    Unit cur, nxt; int ui = 0;
    if (!S.next(0, cur)) return;
    cur.A = uniform_ptr(cur.A); cur.B = uniform_ptr(cur.B);
    f32x4 acc[2][2][4][2];
#pragma unroll
    for (int a = 0; a < 2; ++a)
#pragma unroll
        for (int b = 0; b < 2; ++b)
#pragma unroll
            for (int m = 0; m < 4; ++m)
#pragma unroll
                for (int n = 0; n < 2; ++n) acc[a][b][m][n] = (f32x4){0.f, 0.f, 0.f, 0.f};
    bf16x8 At[4][2], B0[2][2], B1[2][2];
    const char* cA = cur.A; const char* cB = cur.B;
    PG8_STAGE(PG8_SB(0, 0), cB, voffB); PG8_STAGE(PG8_SB(0, 1), cB + hstepB, voffB); PG8_STAGE(PG8_SA(0, 0), cA, voffA); PG8_STAGE(PG8_SA(0, 1), cA + hstepA, voffA);
    if (wr == 1) PG8_BAR;
    PG8_WAIT_V(2); PG8_BAR;
    PG8_STAGE(PG8_SB(1, 0), cB + kstep, voffB); PG8_STAGE(PG8_SA(1, 0), cA + kstep, voffA); PG8_STAGE(PG8_SB(1, 1), cB + hstepB + kstep, voffB);
    PG8_WAIT_V(6); PG8_BAR;
    for (;;) {
        const bool has_next = S.next(ui + 1, nxt);
        const char* nA = uniform_ptr(has_next ? nxt.A : cA); const char* nB = uniform_ptr(has_next ? nxt.B : cB);
#pragma unroll 1
        for (int t = 0; t < nt; t += 2) {
            const bool last = (t == nt - 2);
            const char* a1 = cA + (size_t)(t + 1) * kstep;
            const char* a2 = last ? nA : cA + (size_t)(t + 2) * kstep; const char* b2 = last ? nB : cB + (size_t)(t + 2) * kstep;
            const char* a3 = a2 + kstep; const char* b3 = b2 + kstep;
            PG8_LDB(B0, 0, 0); PG8_LDB(B1, 0, 1); PG8_SCHED; PG8_LDA(At, 0, 0); PG8_STAGE(PG8_SA(1, 1), a1 + hstepA, voffA);
            PG8_WAIT_V(8); PG8_WAIT_L(0); PG8_BAR; PG8_MMA(0, 0, At, B0); PG8_MMA(0, 1, At, B1); PG8_BAR; PG8_SCHED;
            PG8_LDA(At, 0, 1); PG8_STAGE(PG8_SB(0, 0), b2, voffB); PG8_STAGE(PG8_SB(0, 1), b2 + hstepB, voffB); PG8_STAGE(PG8_SA(0, 0), a2, voffA);
            PG8_WAIT_V(8); PG8_WAIT_L(0); PG8_BAR; PG8_MMA(1, 0, At, B0); PG8_MMA(1, 1, At, B1); PG8_BAR; PG8_SCHED;
            PG8_LDB(B0, 1, 0); PG8_LDB(B1, 1, 1); PG8_SCHED; PG8_LDA(At, 1, 0); PG8_STAGE(PG8_SA(0, 1), a2 + hstepA, voffA);
            PG8_WAIT_V(8); PG8_WAIT_L(0); PG8_BAR; PG8_MMA(0, 0, At, B0); PG8_MMA(0, 1, At, B1); PG8_BAR; PG8_SCHED;
            PG8_LDA(At, 1, 1); PG8_STAGE(PG8_SB(1, 0), b3, voffB); PG8_STAGE(PG8_SB(1, 1), b3 + hstepB, voffB); PG8_STAGE(PG8_SA(1, 0), a3, voffA);
            PG8_WAIT_V(8); PG8_WAIT_L(0); PG8_BAR; PG8_MMA(1, 0, At, B0); PG8_MMA(1, 1, At, B1); PG8_BAR; PG8_SCHED;
        }
        if (wr == 0) PG8_BAR;
        if constexpr (FP8) asm volatile("s_nop 15\n\ts_nop 15\n\ts_nop 15" ::: "memory");
        if constexpr (I8) {
#pragma unroll
            for (int a = 0; a < 2; ++a)
#pragma unroll
                for (int b = 0; b < 2; ++b)
#pragma unroll
                    for (int m = 0; m < 4; ++m)
#pragma unroll
                        for (int n = 0; n < 2; ++n) acc[a][b][m][n] = __builtin_convertvector(__builtin_bit_cast(i32x4, acc[a][b][m][n]), f32x4); }
        if constexpr (Epi::INPLACE) { E.inplace(acc, cur, wr, wc, fr, fq); if (!has_next) break; }
        else {
        E(acc, cur, wr, wc, fr, fq);
        if (!has_next) break;
#pragma unroll
        for (int a = 0; a < 2; ++a)
#pragma unroll
            for (int b = 0; b < 2; ++b)
#pragma unroll
                for (int m = 0; m < 4; ++m)
#pragma unroll
                    for (int n = 0; n < 2; ++n) { f32x2 z0, z1; asm volatile("v_mov_b64 %0, 0\n\tv_mov_b64 %1, 0" : "=v"(z0), "=v"(z1)); acc[a][b][m][n] = (f32x4){z0.x, z0.y, z1.x, z1.y}; }
        }
        cur = nxt; cA = nA; cB = nB; ++ui;
        if (wr == 1) PG8_BAR;
    }
    PG8_WAIT_V(0);
    PG8_BAR;
#undef PG8_SA
#undef PG8_SB
#undef PG8_STAGE
#undef PG8_LDA
#undef PG8_LDB
#undef PG8_MMA
#undef PG8_CAT
#undef PG8_WAIT_V
#undef PG8_WAIT_L
#undef PG8_BAR
#undef PG8_SCHED
}

struct SchedPlain {
    TileOrder o; const char* A; const char* B; size_t tA, tB;
    __device__ __forceinline__ bool next(int i, Unit& u) const { if (!o.tile(i, u.pm, u.pn)) return false; u.kind = 0; u.A = A + (size_t)u.pm * tA; u.B = B + (size_t)u.pn * tB; return true; }
};
struct SchedWin {
    TileOrder o; const char* A; const char* B; size_t tA, tB; int nlo, skip, boff;
    __device__ __forceinline__ bool next(int i, Unit& u) const { int q; if (!o.tile(i, u.pm, q)) return false; u.pn = q < nlo ? q : q + skip; u.kind = 0;
        u.A = A + (size_t)u.pm * tA; u.B = B + (size_t)(u.pn - boff) * tB; return true; }
};
struct SchedBranch {
    TileOrder o; const char* abase; const char* W; int f8;
    __device__ __forceinline__ bool next(int i, Unit& u) const {
        const int ti = i / 3, k = i - ti * 3; if (!o.tile(ti, u.pm, u.pn)) return false; u.kind = k;
        const int aoff = f8 ? ((k == 0) ? A8_HC : (k == 1 ? A8_SGU : A8_ATT)) : 2 * ((k == 0) ? A_HC : (k == 1 ? A_SGU : A_Q));
        const size_t wb = f8 ? 1 : 2;
        u.A = abase + (size_t)aoff + (size_t)u.pm * (256 * (size_t)LDA * 2); u.B = W + (size_t)k * (1024 * 512 * wb) + (size_t)u.pn * (256 * 512 * wb); return true; }
};
struct SchedMoe {
    TileOrder o; const char* A; const char* B; size_t tA, tB, bexp; int tp1, tp2, tp3, tp4, tp5, tp6, tp7;
    __device__ __forceinline__ bool next(int i, Unit& u) const { if (!o.tile(i, u.pm, u.pn)) return false;
        const int pm = u.pm; const int e = (pm >= tp1) + (pm >= tp2) + (pm >= tp3) + (pm >= tp4) + (pm >= tp5) + (pm >= tp6) + (pm >= tp7);
        u.kind = e; u.A = A + (size_t)pm * tA; u.B = B + (size_t)e * bexp + (size_t)u.pn * tB; return true; }
};

struct SchedTail {
    SchedMoe m; int pm, pn;
    __device__ __forceinline__ bool next(int i, Unit& u) const { if (i != 0) return false; u.pm = pm; u.pn = pn;
        const int e = (pm >= m.tp1) + (pm >= m.tp2) + (pm >= m.tp3) + (pm >= m.tp4) + (pm >= m.tp5) + (pm >= m.tp6) + (pm >= m.tp7);
        u.kind = e; u.A = m.A + (size_t)pm * m.tA; u.B = m.B + (size_t)e * m.bexp + (size_t)pn * m.tB; return true; }
};

struct RowScale {
    const LAS float* tab; const float* part; int p0, p1, p2, p3;
    __device__ __forceinline__ float row(int p, int lrow, int grow, int fq) const {
        const int sl = (p == p0) ? 0 : (p == p1) ? 1 : (p == p2) ? 2 : (p == p3) ? 3 : -1;
        if (sl >= 0) return tab[sl * 256 + lrow];
        const f32x4 q = *(const f32x4*)(part + (size_t)grow * 16 + 4 * fq);
        float sm = (q[0] + q[1]) + (q[2] + q[3]); sm += __shfl_xor(sm, 16); sm += __shfl_xor(sm, 32);
        return __builtin_amdgcn_rsqf(sm * (1.0f / DM) + EPS);
    }
};
struct EpiWin {
    static constexpr bool INPLACE = false; static constexpr bool PERM = true;
    bf16* a; const float* bgate; const LAS float* lbias; float sc; unsigned char* g8; RowScale rsc;
    __device__ __forceinline__ void operator()(const f32x4 (&acc)[2][2][4][2], const Unit& u, int wr, int wc, int fr, int fq) const {
        asm volatile("" : "+v"(fr), "+v"(fq));
        const int row0 = u.pm * BM + wr * 64 + fr, col0 = u.pn * BM + wc * 32 + 8 * fq;
        if (u.pn < 4) {
            const int gc0 = u.pn * HALF + wc * 32 + 8 * fq;
#pragma unroll
            for (int ai = 0; ai < 2; ++ai)
#pragma unroll
                for (int m = 0; m < 4; ++m) {
                    const float sr = rsc.tab ? sc * rsc.row(u.pm, ai * HALF + wr * 64 + m * 16 + fr, row0 + ai * HALF + m * 16, fq) : sc;
                    const float c1 = -sr * LOG2E;
                    f32x4 e0 = acc[ai][1][m][0] * c1, e1 = acc[ai][1][m][1] * c1;
#pragma unroll
                    for (int j = 0; j < 4; ++j) { e0[j] = __builtin_amdgcn_exp2f(e0[j]); e1[j] = __builtin_amdgcn_exp2f(e1[j]); }
                    e0 = e0 + 1.0f; e1 = e1 + 1.0f;
#pragma unroll
                    for (int j = 0; j < 4; ++j) { e0[j] = __builtin_amdgcn_rcpf(e0[j]); e1[j] = __builtin_amdgcn_rcpf(e1[j]); }
                    const f32x4 r0 = acc[ai][0][m][0] * sr * e0, r1 = acc[ai][0][m][1] * sr * e1;
                    u32x4 w; w.x = cvt_pk_bf16(r0[0], r0[1]); w.y = cvt_pk_bf16(r0[2], r0[3]); w.z = cvt_pk_bf16(r1[0], r1[1]); w.w = cvt_pk_bf16(r1[2], r1[3]);
                    *(u32x4*)(a + (size_t)(row0 + ai * HALF + m * 16) * LDA + A_CONV + gc0) = w; }
            return;
        }
        const int act = (u.pn >= 12 && u.pn < 24) ? 2 : ((u.pn >= 4 && u.pn < 8) ? 1 : 0);
        const int dcol = (u.pn < 12) ? col0 : col0 - (6144 - A_V);
        const float qsc = (u.pn == 8 || u.pn == 9) ? 0.125f * LOG2E : 1.0f;
        f32x4 bv[2][2];
#pragma unroll
        for (int bj = 0; bj < 2; ++bj)
#pragma unroll
            for (int n = 0; n < 2; ++n) bv[bj][n] = (act == 2) ? *(const LAS f32x4*)(lbias + (col0 - G_COL0) + bj * HALF + 4 * n) * (-LOG2E) - 8.0f : (f32x4){0.f, 0.f, 0.f, 0.f};
#pragma unroll
        for (int ai = 0; ai < 2; ++ai)
#pragma unroll
            for (int m = 0; m < 4; ++m) { bf16* rowp = a + (size_t)(row0 + ai * HALF + m * 16) * LDA + dcol;
                const float sr = (rsc.tab ? sc * rsc.row(u.pm, ai * HALF + wr * 64 + m * 16 + fr, row0 + ai * HALF + m * 16, fq) : sc) * ((act == 2) ? -LOG2E : qsc);
                u32x4 gw = (u32x4){0u, 0u, 0u, 0u};
#pragma unroll
                for (int bj = 0; bj < 2; ++bj) { f32x4 v0 = acc[ai][bj][m][0] * sr + bv[bj][0], v1 = acc[ai][bj][m][1] * sr + bv[bj][1];
                    if (act == 1) { f32x2 p = gelu_pk((f32x2){v0[0], v0[1]}), q = gelu_pk((f32x2){v0[2], v0[3]}), s = gelu_pk((f32x2){v1[0], v1[1]}), t = gelu_pk((f32x2){v1[2], v1[3]});
                        v0 = (f32x4){p.x, p.y, q.x, q.y}; v1 = (f32x4){s.x, s.y, t.x, t.y}; }
                    if (act == 2) {
                        unsigned q0 = 0u, q1 = 0u;
#pragma unroll
                        for (int j = 0; j < 4; ++j) { q0 = __builtin_amdgcn_cvt_pk_u8_f32(fmaxf(__builtin_amdgcn_rcpf(__builtin_amdgcn_exp2f(v0[j]) + 0.00390625f), 1.0f), j, q0); q1 = __builtin_amdgcn_cvt_pk_u8_f32(fmaxf(__builtin_amdgcn_rcpf(__builtin_amdgcn_exp2f(v1[j]) + 0.00390625f), 1.0f), j, q1); }
                        if (bj == 0) { gw.x = q0; gw.y = q1; }
                        else { gw.z = q0; gw.w = q1;
                            *(u32x4*)(g8 + (size_t)(row0 + ai * HALF + m * 16) * NGATE + (u.pn - 12) * BM + wc * 64 + fq * 16) = gw; }
                    } else {
                    u32x4 w; w.x = cvt_pk_bf16(v0[0], v0[1]); w.y = cvt_pk_bf16(v0[2], v0[3]); w.z = cvt_pk_bf16(v1[0], v1[1]); w.w = cvt_pk_bf16(v1[2], v1[3]);
                    *(u32x4*)(rowp + bj * HALF) = w; } } }
    }
};
struct EpiBf16Plain {
    static constexpr bool INPLACE = false; static constexpr bool PERM = true;
    bf16* O; int ldc; float sc; RowScale csc;
    __device__ __forceinline__ void operator()(const f32x4 (&acc)[2][2][4][2], const Unit& u, int wr, int wc, int fr, int fq) const {
        asm volatile("" : "+v"(fr), "+v"(fq));
        const int row0 = u.pm * BM + wr * 64 + fr, col0 = u.pn * BM + wc * 32 + 8 * fq;
        f32x4 cs[2][2];
#pragma unroll
        for (int bj = 0; bj < 2; ++bj)
#pragma unroll
            for (int n = 0; n < 2; ++n) { cs[bj][n] = (f32x4){sc, sc, sc, sc};
                if (csc.tab) {
#pragma unroll
                    for (int j = 0; j < 4; ++j) cs[bj][n][j] = sc * csc.row(u.pn, bj * HALF + wc * 32 + 8 * fq + 4 * n + j, u.pn * BM + bj * HALF + wc * 32 + 8 * fq + 4 * n + j, fq); } }
#pragma unroll
        for (int ai = 0; ai < 2; ++ai)
#pragma unroll
            for (int m = 0; m < 4; ++m) { bf16* rowp = O + (size_t)(row0 + ai * HALF + m * 16) * ldc + col0;
#pragma unroll
                for (int bj = 0; bj < 2; ++bj) { const f32x4 v0 = acc[ai][bj][m][0] * cs[bj][0], v1 = acc[ai][bj][m][1] * cs[bj][1];
                    u32x4 w; w.x = cvt_pk_bf16(v0[0], v0[1]); w.y = cvt_pk_bf16(v0[2], v0[3]); w.z = cvt_pk_bf16(v1[0], v1[1]); w.w = cvt_pk_bf16(v1[2], v1[3]);
                    *(u32x4*)(rowp + bj * HALF) = w; } }
    }
};
struct EpiSwigluF8 {
    static constexpr bool INPLACE = false; static constexpr bool PERM = true;
    unsigned char* O; int ldc; float si, so; RowScale rsc;
    __device__ __forceinline__ void operator()(const f32x4 (&acc)[2][2][4][2], const Unit& u, int wr, int wc, int fr, int fq) const {
        asm volatile("" : "+v"(fr), "+v"(fq));
        const int row0 = u.pm * BM + wr * 64 + fr, col0 = u.pn * HALF + wc * 32 + 8 * fq;
#pragma unroll
        for (int ai = 0; ai < 2; ++ai)
#pragma unroll
            for (int m = 0; m < 4; ++m) { unsigned char* rowp = O + (size_t)(row0 + ai * HALF + m * 16) * ldc + col0;
                const float sr = rsc.tab ? si * rsc.row(u.pm, ai * HALF + wr * 64 + m * 16 + fr, row0 + ai * HALF + m * 16, fq) : si;
                const float c1 = -sr * LOG2E, c2 = sr * sr * so;
                f32x4 e0 = acc[ai][0][m][0] * c1, e1 = acc[ai][0][m][1] * c1; const f32x4 p0 = acc[ai][0][m][0] * acc[ai][1][m][0] * c2, p1 = acc[ai][0][m][1] * acc[ai][1][m][1] * c2;
#pragma unroll
                for (int j = 0; j < 4; ++j) { e0[j] = __builtin_amdgcn_exp2f(e0[j]); e1[j] = __builtin_amdgcn_exp2f(e1[j]); }
                e0 = e0 + 1.0f; e1 = e1 + 1.0f;
#pragma unroll
                for (int j = 0; j < 4; ++j) { e0[j] = __builtin_amdgcn_rcpf(e0[j]); e1[j] = __builtin_amdgcn_rcpf(e1[j]); }
                const f32x4 r0 = p0 * e0, r1 = p1 * e1;
                u32x2 w; w.x = cvt4_fp8(r0[0], r0[1], r0[2], r0[3]); w.y = cvt4_fp8(r1[0], r1[1], r1[2], r1[3]);
                *(u32x2*)rowp = w; }
    }
};
__device__ __forceinline__ float ub0(unsigned p) { float f; asm("v_cvt_f32_ubyte0 %0, %1" : "=v"(f) : "v"(p)); return f; }
__device__ __forceinline__ float ub1(unsigned p) { float f; asm("v_cvt_f32_ubyte1 %0, %1" : "=v"(f) : "v"(p)); return f; }
__device__ __forceinline__ float ub2(unsigned p) { float f; asm("v_cvt_f32_ubyte2 %0, %1" : "=v"(f) : "v"(p)); return f; }
__device__ __forceinline__ float ub3(unsigned p) { float f; asm("v_cvt_f32_ubyte3 %0, %1" : "=v"(f) : "v"(p)); return f; }
struct EpiBranch {
    static constexpr bool PERM = true, INPLACE = true;
    bf16* a; const unsigned char* g8; int mf8; float osc;
    __device__ __forceinline__ void inplace(f32x4 (&acc)[2][2][4][2], const Unit& u, int wr, int wc, int fr, int fq) const {
        asm volatile("" : "+v"(fr), "+v"(fq));
        const int row0 = u.pm * BM + wr * 64 + fr, col0 = u.pn * BM + wc * 32 + 8 * fq, k = u.kind, gcol = u.pn * BM + wc * 64 + fq * 16;
        if (k < 2) {
#pragma unroll
            for (int ai = 0; ai < 2; ++ai) {
                u32x4 qa[4], qb[4];
#pragma unroll
                for (int m = 0; m < 4; ++m) { const unsigned char* gp = g8 + (size_t)(row0 + ai * HALF + m * 16) * NGATE + k * 1024 + gcol;
                    qa[m] = *(const u32x4*)gp; qb[m] = *(const u32x4*)(gp + 1024); }
#pragma unroll
                for (int m = 0; m < 4; ++m)
#pragma unroll
                    for (int bj = 0; bj < 2; ++bj) { u32x2 x, y; x.x = bj ? qa[m].z : qa[m].x; x.y = bj ? qa[m].w : qa[m].y; y.x = bj ? qb[m].z : qb[m].x; y.y = bj ? qb[m].w : qb[m].y;
                        f32x4 r0, r1;
                        r0[0] = ub0(x.x) * __builtin_amdgcn_rcpf(ub0(y.x)); r0[1] = ub1(x.x) * __builtin_amdgcn_rcpf(ub1(y.x)); r0[2] = ub2(x.x) * __builtin_amdgcn_rcpf(ub2(y.x)); r0[3] = ub3(x.x) * __builtin_amdgcn_rcpf(ub3(y.x));
                        r1[0] = ub0(x.y) * __builtin_amdgcn_rcpf(ub0(y.y)); r1[1] = ub1(x.y) * __builtin_amdgcn_rcpf(ub1(y.y)); r1[2] = ub2(x.y) * __builtin_amdgcn_rcpf(ub2(y.y)); r1[3] = ub3(x.y) * __builtin_amdgcn_rcpf(ub3(y.y));
                        acc[ai][bj][m][0] = acc[ai][bj][m][0] * r0; acc[ai][bj][m][1] = acc[ai][bj][m][1] * r1; }
            }
            return;
        }
#pragma unroll
        for (int ai = 0; ai < 2; ++ai) {
            u32x4 gq[4];
#pragma unroll
            for (int m = 0; m < 4; ++m) gq[m] = *(const u32x4*)(g8 + (size_t)(row0 + ai * HALF + m * 16) * NGATE + 2048 + gcol);
#pragma unroll
            for (int m = 0; m < 4; ++m)
#pragma unroll
                for (int bj = 0; bj < 2; ++bj) { bf16* rowp = a + (size_t)(row0 + ai * HALF + m * 16) * LDA + A_G + col0 + bj * HALF;
                    const f32x4 v0 = acc[ai][bj][m][0], v1 = acc[ai][bj][m][1]; u32x2 g; g.x = bj ? gq[m].z : gq[m].x; g.y = bj ? gq[m].w : gq[m].y;
                    if (mf8) { const f32x4 s0 = v0 * osc, s1 = v1 * osc; u32x2 w8;
                        if (mf8 == 2) { w8.x = cvt4_i8(ub0(g.x) * s0[0], ub1(g.x) * s0[1], ub2(g.x) * s0[2], ub3(g.x) * s0[3]); w8.y = cvt4_i8(ub0(g.y) * s1[0], ub1(g.y) * s1[1], ub2(g.y) * s1[2], ub3(g.y) * s1[3]); } else {
                        w8.x = cvt4_fp8(ub0(g.x) * s0[0], ub1(g.x) * s0[1], ub2(g.x) * s0[2], ub3(g.x) * s0[3]); w8.y = cvt4_fp8(ub0(g.y) * s1[0], ub1(g.y) * s1[1], ub2(g.y) * s1[2], ub3(g.y) * s1[3]); }
                        *(u32x2*)((unsigned char*)a + (size_t)(row0 + ai * HALF + m * 16) * (LDA * 2) + A_G * 2 + col0 + bj * HALF) = w8;
                    } else {
                    u32x4 w;
                    w.x = cvt_pk_bf16(ub0(g.x) * v0[0], ub1(g.x) * v0[1]); w.y = cvt_pk_bf16(ub2(g.x) * v0[2], ub3(g.x) * v0[3]);
                    w.z = cvt_pk_bf16(ub0(g.y) * v1[0], ub1(g.y) * v1[1]); w.w = cvt_pk_bf16(ub2(g.y) * v1[2], ub3(g.y) * v1[3]);
                    *(u32x4*)rowp = w; }
                    acc[ai][bj][m][0] = (f32x4){0.f, 0.f, 0.f, 0.f}; acc[ai][bj][m][1] = (f32x4){0.f, 0.f, 0.f, 0.f}; }
        }
    }
};
struct EpiRes {
    static constexpr bool INPLACE = false; static constexpr bool PERM = true;
    bf16* h; unsigned char* xf8; const float* gain; float* part; float sc; int xo, nrm; float sx8;
    __device__ __forceinline__ void operator()(const f32x4 (&acc)[2][2][4][2], const Unit& u, int wr, int wc, int fr, int fq) const {
        asm volatile("" : "+v"(fr), "+v"(fq));
        const int row0 = u.pm * BM + wr * 64 + fr, col0 = u.pn * BM + wc * 32 + 8 * fq;
        f32x4 gv[2][2];
#pragma unroll
        for (int bj = 0; bj < 2; ++bj)
#pragma unroll
            for (int n = 0; n < 2; ++n) { gv[bj][n] = (f32x4){0.f, 0.f, 0.f, 0.f}; if (xo) gv[bj][n] = *(const f32x4*)(gain + col0 + bj * HALF + 4 * n) * (xo == 2 ? sx8 : F8_SX); }
#pragma unroll
        for (int ai = 0; ai < 2; ++ai) {
            u32x4 bs[4][2];
#pragma unroll
            for (int m = 0; m < 4; ++m)
#pragma unroll
                for (int bj = 0; bj < 2; ++bj) bs[m][bj] = *(const u32x4*)(h + (size_t)(row0 + ai * HALF + m * 16) * DM + col0 + bj * HALF);
#pragma unroll
            for (int m = 0; m < 4; ++m) { const int row = row0 + ai * HALF + m * 16; float ss = 0.f;
#pragma unroll
                for (int bj = 0; bj < 2; ++bj) { const u32x4 b = bs[m][bj]; const size_t off = (size_t)row * DM + col0 + bj * HALF;
                    const f32x4 o0 = (f32x4){bflo(b.x), bfhi(b.x), bflo(b.y), bfhi(b.y)} + acc[ai][bj][m][0] * sc, o1 = (f32x4){bflo(b.z), bfhi(b.z), bflo(b.w), bfhi(b.w)} + acc[ai][bj][m][1] * sc;
                    u32x4 w; w.x = cvt_pk_bf16(o0[0], o0[1]); w.y = cvt_pk_bf16(o0[2], o0[3]); w.z = cvt_pk_bf16(o1[0], o1[1]); w.w = cvt_pk_bf16(o1[2], o1[3]);
                    *(u32x4*)(h + off) = w;
                    if (xo) { const f32x4 x0 = o0 * gv[bj][0], x1 = o1 * gv[bj][1]; u32x2 q;
                        if (xo == 2) { q.x = cvt4_i8(x0[0], x0[1], x0[2], x0[3]); q.y = cvt4_i8(x1[0], x1[1], x1[2], x1[3]); } else { q.x = cvt4_fp8(x0[0], x0[1], x0[2], x0[3]); q.y = cvt4_fp8(x1[0], x1[1], x1[2], x1[3]); }
                        *(u32x2*)(xf8 + off) = q; }
                    if (nrm) ss += ((o0[0] * o0[0] + o0[1] * o0[1]) + (o0[2] * o0[2] + o0[3] * o0[3])) + ((o1[0] * o1[0] + o1[1] * o1[1]) + (o1[2] * o1[2] + o1[3] * o1[3])); }
                if (nrm) { ss += __shfl_xor(ss, 16); ss += __shfl_xor(ss, 32); if (fq == 0) part[(size_t)row * 16 + u.pn * 4 + wc] = ss; } }
            asm volatile("" ::: "memory");
        }
    }
};
struct EpiSwiglu {
    static constexpr bool INPLACE = false; static constexpr bool PERM = true;
    bf16* O; int ldc; RowScale rsc; float si;
    __device__ __forceinline__ void operator()(const f32x4 (&acc)[2][2][4][2], const Unit& u, int wr, int wc, int fr, int fq) const {
        asm volatile("" : "+v"(fr), "+v"(fq));
        const int row0 = u.pm * BM + wr * 64 + fr, col0 = u.pn * HALF + wc * 32 + 8 * fq;
#pragma unroll
        for (int ai = 0; ai < 2; ++ai)
#pragma unroll
            for (int m = 0; m < 4; ++m) { bf16* rowp = O + (size_t)(row0 + ai * HALF + m * 16) * ldc + col0;
                const float sr = (rsc.tab ? rsc.row(u.pm, ai * HALF + wr * 64 + m * 16 + fr, row0 + ai * HALF + m * 16, fq) : 1.0f) * si;
                const float c1 = -sr * LOG2E, c2 = sr * sr;
                f32x4 e0 = acc[ai][0][m][0] * c1, e1 = acc[ai][0][m][1] * c1; const f32x4 p0 = acc[ai][0][m][0] * acc[ai][1][m][0] * c2, p1 = acc[ai][0][m][1] * acc[ai][1][m][1] * c2;
#pragma unroll
                for (int j = 0; j < 4; ++j) { e0[j] = __builtin_amdgcn_exp2f(e0[j]); e1[j] = __builtin_amdgcn_exp2f(e1[j]); }
                e0 = e0 + 1.0f; e1 = e1 + 1.0f;
#pragma unroll
                for (int j = 0; j < 4; ++j) { e0[j] = __builtin_amdgcn_rcpf(e0[j]); e1[j] = __builtin_amdgcn_rcpf(e1[j]); }
                const f32x4 r0 = p0 * e0, r1 = p1 * e1;
                u32x4 w; w.x = cvt_pk_bf16(r0[0], r0[1]); w.y = cvt_pk_bf16(r0[2], r0[3]); w.z = cvt_pk_bf16(r1[0], r1[1]); w.w = cvt_pk_bf16(r1[2], r1[3]);
                *(u32x4*)rowp = w; }
    }
};
}

namespace fa {
using bf16=__hip_bfloat16;
using bf16x8=__attribute__((ext_vector_type(8)))short;
using s16x4=__attribute__((ext_vector_type(4)))short;
using f32x16=__attribute__((ext_vector_type(16)))float;
using u32x4=__attribute__((ext_vector_type(4)))unsigned;
constexpr int BATCH=4,NHEAD=8,SEQ=8192,D=64,DM=5120;
constexpr int NW=8,QBLK=32,UW=4,QB=QBLK*UW,KVBLK=64,NQB=SEQ/QB;
constexpr int ATTN_PITCH=DM, ATTN_UNIT_ROWS=QB;
__device__ __forceinline__ int crow(int r,int hi){return (r&3)+8*(r>>2)+4*hi;}
#define SBAR() __builtin_amdgcn_sched_barrier(0)
typedef const __attribute__((address_space(3))) float* lds_cfptr;
__device__ __forceinline__ void biasmask(f32x16&p0,f32x16&p1,int dj,int qi,int hi,lds_cfptr tbs){
  if(dj<0||dj>8){
    #pragma unroll
    for(int r=0;r<16;++r){p0[r]=-1000.f;p1[r]=-1000.f;}
  } else if(dj<3){ const int base=64*dj+qi-4*hi+63;
    #pragma unroll
    for(int r=0;r<16;++r){ const int i0=base-((r&3)+8*(r>>2)), i1=i0-32; p0[r]+=tbs[i0>191?191:i0]; p1[r]+=tbs[i1>191?191:i1]; }
  }
}

constexpr int NSLOT=3, SLOTB=8192;
constexpr int LDS_K=0, LDS_V=NSLOT*SLOTB, LDS_UNIT=2*NSLOT*SLOTB, LDS_WS=2*LDS_UNIT, LDS_OST=LDS_WS+NW*64*4, LDS_BYTES=LDS_OST+NW*4096;
constexpr float C2=0.125f*1.4426950408889634f;
__device__ __forceinline__ void glds16(const void*gsrc,unsigned lds_dst){unsigned keep;
  asm volatile("s_mov_b32 %0, m0\n\ts_mov_b32 m0, %2\n\ts_nop 0\n\tglobal_load_lds_dwordx4 %1, off\n\ts_mov_b32 m0, %0":"=&s"(keep):"v"(gsrc),"s"(lds_dst):"memory");}
__device__ __forceinline__ float max3f(float a,float b,float c){float r;asm("v_max3_f32 %0, %1, %2, %3":"=v"(r):"v"(a),"v"(b),"v"(c));return r;}
__device__ __forceinline__ float max2f(float a,float b){float r;asm("v_max_f32_e32 %0, %1, %2":"=v"(r):"v"(a),"v"(b));return r;}
__device__ __forceinline__ float fadd_s(float a,float b){float r;asm("v_add_f32_e32 %0, %1, %2":"=v"(r):"v"(a),"v"(b));return r;}
__device__ __forceinline__ float fsub_s(float a,float b){float r;asm("v_sub_f32_e32 %0, %1, %2":"=v"(r):"v"(a),"v"(b));return r;}
typedef float f32x2_t __attribute__((ext_vector_type(2))); typedef __bf16 bf16x2_t __attribute__((ext_vector_type(2)));
__device__ __forceinline__ unsigned cvtpk_s(float lo,float hi){f32x2_t v={lo,hi};bf16x2_t b=__builtin_convertvector(v,bf16x2_t);return __builtin_bit_cast(unsigned,b);}
#define WAIT_BAR(N) asm volatile("s_waitcnt vmcnt(" #N ") lgkmcnt(0)\n\ts_barrier":::"memory")

__device__ __forceinline__ void qkt(f32x16&p0,f32x16&p1,const char*Kslot,const bf16x8*qr,const f32x16&negm,int r32,int hi){
  const char*kb=Kslot+hi*1024+r32*16;
  #pragma unroll
  for(int d0=0;d0<4;++d0){
    const bf16x8 b0=*reinterpret_cast<const bf16x8*>(kb+d0*2048);
    const bf16x8 b1=*reinterpret_cast<const bf16x8*>(kb+d0*2048+512);
    if(d0==0){p0=__builtin_amdgcn_mfma_f32_32x32x16_bf16(b0,qr[0],negm,0,0,0);p1=__builtin_amdgcn_mfma_f32_32x32x16_bf16(b1,qr[0],negm,0,0,0);}
    else{p0=__builtin_amdgcn_mfma_f32_32x32x16_bf16(b0,qr[d0],p0,0,0,0);p1=__builtin_amdgcn_mfma_f32_32x32x16_bf16(b1,qr[d0],p1,0,0,0);}}
}
typedef __attribute__((address_space(3))) const char* lds_cptr;
typedef short v4i16_t __attribute__((ext_vector_type(4)));
__device__ __forceinline__ void kload8(bf16x8*kf,lds_cptr kp){
  kf[0]=*(const __attribute__((address_space(3))) bf16x8*)(kp);      kf[1]=*(const __attribute__((address_space(3))) bf16x8*)(kp+512);
  kf[2]=*(const __attribute__((address_space(3))) bf16x8*)(kp+2048); kf[3]=*(const __attribute__((address_space(3))) bf16x8*)(kp+2560);
  kf[4]=*(const __attribute__((address_space(3))) bf16x8*)(kp+4096); kf[5]=*(const __attribute__((address_space(3))) bf16x8*)(kp+4608);
  kf[6]=*(const __attribute__((address_space(3))) bf16x8*)(kp+6144); kf[7]=*(const __attribute__((address_space(3))) bf16x8*)(kp+6656);
}
__device__ __forceinline__ void kload2(bf16x8*kf,lds_cptr kp,int j){ kf[2*j]=*(const __attribute__((address_space(3))) bf16x8*)(kp+j*2048); kf[2*j+1]=*(const __attribute__((address_space(3))) bf16x8*)(kp+j*2048+512); }
__device__ __forceinline__ s16x4 vtr(lds_cptr p){ return __builtin_bit_cast(s16x4,__builtin_amdgcn_ds_read_tr16_b64_v4i16((__attribute__((address_space(3))) v4i16_t*)p)); }
__device__ __forceinline__ float rowmax(const f32x16&p0,const f32x16&p1){
  float a=max3f(p0[0],p0[1],p1[0]),b=max3f(p0[2],p0[3],p1[1]);a=max3f(a,p1[2],p1[3]);
  #pragma unroll
  for(int r=4;r<16;r+=4){a=max3f(a,p0[r],p0[r+1]);b=max3f(b,p0[r+2],p0[r+3]);a=max3f(a,p1[r],p1[r+1]);b=max3f(b,p1[r+2],p1[r+3]);}
  const float m=max2f(a,b);
  auto rr=__builtin_amdgcn_permlane32_swap(__float_as_uint(m),__float_as_uint(m),false,false);
  return max2f(__uint_as_float(rr[0]),__uint_as_float(rr[1]));
}
__device__ __forceinline__ void pv(f32x16*o,int vb,bf16x8 pa0,bf16x8 pa1,bf16x8 pa2,bf16x8 pa3){
  #pragma unroll
  for(int d0=0;d0<2;++d0){s16x4 lo[4],hi[4];
    #pragma unroll
    for(int ks=0;ks<4;++ks){
      asm volatile("ds_read_b64_tr_b16 %0,%1 offset:%c2":"=&v"(lo[ks]):"v"(vb),"i"(d0*4096+ks*1024):"memory");
      asm volatile("ds_read_b64_tr_b16 %0,%1 offset:%c2":"=&v"(hi[ks]):"v"(vb),"i"(d0*4096+ks*1024+512):"memory");}
    asm volatile("s_waitcnt lgkmcnt(0)":::"memory");SBAR();
    #define PK(k) (bf16x8){lo[k][0],lo[k][1],lo[k][2],lo[k][3],hi[k][0],hi[k][1],hi[k][2],hi[k][3]}
    o[d0]=__builtin_amdgcn_mfma_f32_32x32x16_bf16(pa0,PK(0),o[d0],0,0,0);
    o[d0]=__builtin_amdgcn_mfma_f32_32x32x16_bf16(pa1,PK(1),o[d0],0,0,0);
    o[d0]=__builtin_amdgcn_mfma_f32_32x32x16_bf16(pa2,PK(2),o[d0],0,0,0);
    o[d0]=__builtin_amdgcn_mfma_f32_32x32x16_bf16(pa3,PK(3),o[d0],0,0,0);
    #undef PK
  }
}

#ifndef ATTN_STORE16
#define ATTN_STORE16(p,v) (*(u32x4*)(p)=(v))
#endif
template<int THRL> __device__ __forceinline__ void attn_unit(int b,int h0,int c0,const bf16*Q,const bf16*__restrict__ K,const bf16*__restrict__ V,bf16*O,unsigned char*O8,char*shm,lds_cfptr tbs){
  int tid_=threadIdx.x; asm volatile("":"+v"(tid_));
  const int tid=tid_,lane=tid&63,r32=lane&31,hi=lane>>5; const int wid=__builtin_amdgcn_readfirstlane(tid>>6);
  const int U=wid>>2, w4=wid&3, ub=U*LDS_UNIT; const int h=h0+U; tbs+=h*192;
  const long rowbase=(long)b*SEQ; const int q0=c0*KVBLK; const int T0=c0>8?c0-8:0;
  const bf16*Qw=Q+(rowbase+q0+w4*QBLK)*DM+h*D;
  const bf16*Kh=K+(rowbase+(long)T0*KVBLK)*DM+h*D,*Vh=V+(rowbase+(long)T0*KVBLK)*DM+h*D;
  const unsigned lds0=(unsigned)(uintptr_t)shm;
  float*wsf=(float*)(shm+LDS_WS)+wid*64;
  const bf16*ksrc=Kh+(long)lane*DM+w4*8;
  const bf16*vsrc=Vh+(long)(16*w4+(lane>>2))*DM+(lane&3)*8;
  const unsigned kdst=lds0+ub+LDS_K+w4*1024, vdst=lds0+ub+LDS_V+w4*1024;
  #define DMA_K(t,slot) do{ glds16(ksrc+(long)(t)*KVBLK*DM,(unsigned)__builtin_amdgcn_readfirstlane(kdst+(slot))); glds16(ksrc+(long)(t)*KVBLK*DM+32,(unsigned)__builtin_amdgcn_readfirstlane(kdst+(slot)+4096)); }while(0)
  #define DMA_V(t,slot) do{ glds16(vsrc+(long)(t)*KVBLK*DM,(unsigned)__builtin_amdgcn_readfirstlane(vdst+(slot))); glds16(vsrc+(long)(t)*KVBLK*DM+32,(unsigned)__builtin_amdgcn_readfirstlane(vdst+(slot)+4096)); }while(0)
  const int vb0=(int)(lds0+ub+LDS_V)+((lane>>4)&1)*32+(lane&3)*8+(4*hi+((lane&15)>>2))*64;
  const char*Kbase=shm+ub+LDS_K; bf16x8 kf[8];
  const lds_cptr shm3=(lds_cptr)shm+ub; const lds_cptr kp0=shm3+LDS_K+hi*1024+r32*16; const lds_cptr vp0=shm3+LDS_V+((lane>>4)&1)*32+(lane&3)*8+(4*hi+((lane&15)>>2))*64;
  const int NT=(c0+2-T0)<4?4:(c0+2-T0);
  DMA_K(0,0);DMA_V(0,0);DMA_K(1,SLOTB);
  bf16x8 qr[4];
  #pragma unroll
  for(int d0=0;d0<4;++d0)qr[d0]=*reinterpret_cast<const bf16x8*>(&Qw[(long)r32*DM+d0*16+hi*8]);
  float mhat=0.f,l_reg=0.f;f32x16 o[2];o[0]=f32x16{};o[1]=f32x16{};f32x16 negm=f32x16{};asm volatile("":"+v"(negm));
  const int cw=c0+(w4>>1), qi=32*(w4&1)+r32;
  #define CMASK(P0,P1,t) biasmask(P0,P1,cw-(T0+(t)),qi,hi,tbs)
  bool resc=false;
  #define START(P0,P1) do{ const float rm=rowmax(P0,P1); resc=false; \
    { const float dl=rm; mhat=fadd_s(mhat,dl); \
      _Pragma("unroll") for(int r=0;r<16;++r){P0[r]=fsub_s(P0[r],dl);P1[r]=fsub_s(P1[r],dl);} \
      _Pragma("unroll") for(int r=0;r<16;++r)negm[r]=-mhat; asm volatile("":"+v"(negm)); } \
    _Pragma("unroll") for(int r=0;r<16;++r)P0[r]=__builtin_amdgcn_exp2f(P0[r]); }while(0)
  #define RESC() do{ if(resc){ asm volatile("s_waitcnt lgkmcnt(0)":::"memory"); \
      _Pragma("unroll") for(int d_=0;d_<2;++d_) _Pragma("unroll") for(int r=0;r<16;++r)o[d_][r]*=wsf[crow(r,hi)]; } }while(0)
  f32x16 pA0,pA1,pB0,pB1;
  int sl_prev=0,sl_cur=0,sl_next=SLOTB;
  #define ROT() do{sl_prev=sl_cur;sl_cur=sl_next;sl_next=(sl_next==(NSLOT-1)*SLOTB)?0:sl_next+SLOTB;}while(0)
  DMA_K(2,2*SLOTB);
  WAIT_BAR(6);
  qkt(pA0,pA1,Kbase,qr,negm,r32,hi);asm volatile("s_nop 15\n\ts_nop 7":"+v"(pA0),"+v"(pA1));CMASK(pA0,pA1,0);
  START(pA0,pA1);
  _Pragma("unroll") for(int r=0;r<16;++r)pA1[r]=__builtin_amdgcn_exp2f(pA1[r]);
  WAIT_BAR(0);
  DMA_K(3,0);DMA_V(1,SLOTB);
  ROT();
  kload8(kf,kp0+sl_cur);
  WAIT_BAR(4);
  s16x4 vlo[8],vhi[8]; u32x4 pw0,pw1,pw2,pw3;
  #define PKW(P,B) cvtpk_s(P[B],P[B+1])
  #define PAF(k) __builtin_bit_cast(bf16x8,pw##k)
  #define VFR(i) (bf16x8){vlo[i][0],vlo[i][1],vlo[i][2],vlo[i][3],vhi[i][0],vhi[i][1],vhi[i][2],vhi[i][3]}
  #define PIN(x) asm volatile("":"+v"(x))
  #define MX3(a,b,c) __builtin_fmaxf(__builtin_fmaxf((a),(b)),(c))
  #define GAPA(MF,A0,A1,A2,A3,W0,W1,PW) do{ MF; sacc+=A0; sacc+=A1; sacc+=A2; sacc+=A3; PIN(sacc); W0; W1; PIN(PW); SBAR(); }while(0)
  #define EX(v) __builtin_amdgcn_exp2f(v)
  #define GAPB(MF,X,B) do{ MF; X[B]=EX(X[B]); X[B+1]=EX(X[B+1]); X[B+2]=EX(X[B+2]); X[B+3]=EX(X[B+3]); PIN(X); SBAR(); }while(0)
  #define VRD(i) do{ vlo[i]=vtr(vp_+(((i)>>2)*4096+((i)&3)*1024)); vhi[i]=vtr(vp_+(((i)>>2)*4096+((i)&3)*1024+512)); }while(0)
  #define KRD(G,j) do{ if(G){ kload2(kf,kp0+sl_next,j); SBAR(); } }while(0)
  #define STEP(C0,C1,P0,P1,t,GK,GV,GL) do{ SBAR(); \
    const lds_cptr vp_=vp0+sl_prev; \
    VRD(0); SBAR(); float sacc=(P0[0]+P0[1]); \
    GAPA(C0=__builtin_amdgcn_mfma_f32_32x32x16_bf16(kf[0],qr[0],negm,0,0,0), P0[2],P0[3],P0[4],P0[5],     pw0[0]=PKW(P0,0), pw0[1]=PKW(P0,2), pw0); \
    VRD(4); SBAR(); GAPA(C1=__builtin_amdgcn_mfma_f32_32x32x16_bf16(kf[1],qr[0],negm,0,0,0), P0[6],P0[7],P0[8],P0[9],     pw0[2]=PKW(P0,4), pw0[3]=PKW(P0,6), pw0); \
    VRD(1); SBAR(); GAPA(C0=__builtin_amdgcn_mfma_f32_32x32x16_bf16(kf[2],qr[1],C0,0,0,0),   P0[10],P0[11],P0[12],P0[13], pw1[0]=PKW(P0,8), pw1[1]=PKW(P0,10), pw1); \
    VRD(5); SBAR(); GAPA(C1=__builtin_amdgcn_mfma_f32_32x32x16_bf16(kf[3],qr[1],C1,0,0,0),   P0[14],P0[15],P1[0],P1[1],   pw1[2]=PKW(P0,12),pw1[3]=PKW(P0,14), pw1); \
    VRD(2); SBAR(); GAPA(C0=__builtin_amdgcn_mfma_f32_32x32x16_bf16(kf[4],qr[2],C0,0,0,0),   P1[2],P1[3],P1[4],P1[5],     pw2[0]=PKW(P1,0), pw2[1]=PKW(P1,2), pw2); \
    VRD(6); SBAR(); GAPA(C1=__builtin_amdgcn_mfma_f32_32x32x16_bf16(kf[5],qr[2],C1,0,0,0),   P1[6],P1[7],P1[8],P1[9],     pw2[2]=PKW(P1,4), pw2[3]=PKW(P1,6), pw2); \
    VRD(3); SBAR(); GAPA(C0=__builtin_amdgcn_mfma_f32_32x32x16_bf16(kf[6],qr[3],C0,0,0,0),   P1[10],P1[11],P1[12],P1[13], pw3[0]=PKW(P1,8), pw3[1]=PKW(P1,10), pw3); \
    VRD(7); SBAR(); GAPA(C1=__builtin_amdgcn_mfma_f32_32x32x16_bf16(kf[7],qr[3],C1,0,0,0),   P1[14],P1[15],0.f,0.f,       pw3[2]=PKW(P1,12),pw3[3]=PKW(P1,14), pw3); \
    l_reg+=sacc; \
    if(GK){DMA_K((t)+3,sl_cur);} if(GV){DMA_V((t)+1,sl_next);} \
    CMASK(C0,C1,t); \
    { float a=MX3(C0[0],C0[1],C1[0]),b=MX3(C0[2],C0[3],C1[1]); a=MX3(a,C1[2],C1[3]); \
      _Pragma("unroll") for(int r=4;r<16;r+=4){a=MX3(a,C0[r],C0[r+1]);b=MX3(b,C0[r+2],C0[r+3]);a=MX3(a,C1[r],C1[r+1]);b=MX3(b,C1[r+2],C1[r+3]);} \
      float rm=__builtin_fmaxf(a,b); { auto rr=__builtin_amdgcn_permlane32_swap(__float_as_uint(rm),__float_as_uint(rm),false,false); rm=__builtin_fmaxf(__uint_as_float(rr[0]),__uint_as_float(rr[1])); } \
      resc=false; \
      if(__builtin_expect(__any(rm>(float)THRL),0)){ const float dl=__builtin_fmaxf(rm,0.f); mhat+=dl; \
        _Pragma("unroll") for(int r=0;r<16;++r){C0[r]-=dl;C1[r]-=dl;} \
        _Pragma("unroll") for(int r=0;r<16;++r)negm[r]=-mhat; asm volatile("":"+v"(negm)); \
        const float f=__builtin_amdgcn_exp2f(-dl); l_reg*=f; if(hi==0)wsf[r32]=f; resc=true; } } \
    SBAR(); \
    GAPB(o[0]=__builtin_amdgcn_mfma_f32_32x32x16_bf16(PAF(0),VFR(0),o[0],0,0,0), C0,0); \
    GAPB(o[1]=__builtin_amdgcn_mfma_f32_32x32x16_bf16(PAF(0),VFR(4),o[1],0,0,0), C0,4); \
    KRD(GL,0); GAPB(o[0]=__builtin_amdgcn_mfma_f32_32x32x16_bf16(PAF(1),VFR(1),o[0],0,0,0), C0,8); \
    KRD(GL,1); GAPB(o[1]=__builtin_amdgcn_mfma_f32_32x32x16_bf16(PAF(1),VFR(5),o[1],0,0,0), C0,12); \
    KRD(GL,2); GAPB(o[0]=__builtin_amdgcn_mfma_f32_32x32x16_bf16(PAF(2),VFR(2),o[0],0,0,0), C1,0); \
    KRD(GL,3); GAPB(o[1]=__builtin_amdgcn_mfma_f32_32x32x16_bf16(PAF(2),VFR(6),o[1],0,0,0), C1,4); \
    GAPB(o[0]=__builtin_amdgcn_mfma_f32_32x32x16_bf16(PAF(3),VFR(3),o[0],0,0,0), C1,8); \
    GAPB(o[1]=__builtin_amdgcn_mfma_f32_32x32x16_bf16(PAF(3),VFR(7),o[1],0,0,0), C1,12); \
    }while(0)
  int t=1;
  for(;t+5<NT;t+=2){
    STEP(pB0,pB1,pA0,pA1,t,true,true,true);     WAIT_BAR(4); RESC(); ROT();
    STEP(pA0,pA1,pB0,pB1,t+1,true,true,true);   WAIT_BAR(4); RESC(); ROT();
  }
  #define ENDW(tt) do{ if((tt)+3<NT){WAIT_BAR(4);} else if((tt)+2<NT){WAIT_BAR(2);} else {WAIT_BAR(0);} }while(0)
  for(;t+1<NT;t+=2){
    STEP(pB0,pB1,pA0,pA1,t,(t+3<NT),(t+1<NT),(t+1<NT));       ENDW(t);   RESC(); ROT();
    STEP(pA0,pA1,pB0,pB1,t+1,(t+4<NT),(t+2<NT),(t+2<NT));     ENDW(t+1); RESC(); ROT();
  }
  STEP(pB0,pB1,pA0,pA1,NT-1,false,false,false); RESC();
  { float sacc=pB0[0]+pB0[1]; _Pragma("unroll") for(int r=2;r<16;++r)sacc+=pB0[r]; _Pragma("unroll") for(int r=0;r<16;++r)sacc+=pB1[r]; l_reg+=sacc;
    pw0=(u32x4){PKW(pB0,0),PKW(pB0,2),PKW(pB0,4),PKW(pB0,6)};pw1=(u32x4){PKW(pB0,8),PKW(pB0,10),PKW(pB0,12),PKW(pB0,14)};pw2=(u32x4){PKW(pB1,0),PKW(pB1,2),PKW(pB1,4),PKW(pB1,6)};pw3=(u32x4){PKW(pB1,8),PKW(pB1,10),PKW(pB1,12),PKW(pB1,14)};
    SBAR(); pv(o,vb0+sl_cur,PAF(0),PAF(1),PAF(2),PAF(3)); }
  #undef PKW
  #undef PAF
  #undef VFR
  #undef PIN
  #undef MX3
  #undef GAPA
  #undef GAPB
  #undef EX
  #undef VRD
  #undef KRD
  #undef STEP
  #undef ENDW
  {auto rr=__builtin_amdgcn_permlane32_swap(__float_as_uint(l_reg),__float_as_uint(l_reg),false,false);l_reg=__uint_as_float(rr[0])+__uint_as_float(rr[1]);}
  if(hi==0)wsf[32+r32]=l_reg;asm volatile("s_waitcnt lgkmcnt(0)":::"memory");
  float rli[16];
  #pragma unroll
  for(int r=0;r<16;++r)rli[r]=__builtin_amdgcn_rcpf(wsf[32+crow(r,hi)]);
  if(O8){ unsigned char*stg8=(unsigned char*)(shm+LDS_OST)+wid*4096;
    unsigned char*O8w=O8+(rowbase+q0+w4*QBLK)*(long)(2*DM)+h*D;
    #pragma unroll
    for(int r=0;r<16;++r){const int orow=crow(r,hi); const float sc_=rli[r]*F8_SX;
      const unsigned pk=(unsigned)__builtin_amdgcn_cvt_pk_fp8_f32(clamp448(o[0][r]*sc_),clamp448(o[1][r]*sc_),0,false);
      stg8[orow*64+r32]=(unsigned char)(pk&0xffu); stg8[orow*64+32+r32]=(unsigned char)((pk>>8)&0xffu);}
    asm volatile("s_waitcnt lgkmcnt(0)":::"memory");
    #pragma unroll
    for(int i=0;i<2;++i){const int row=i*16+(lane>>2),ch=lane&3; const u32x4 v=*(const u32x4*)(stg8+row*64+ch*16); ATTN_STORE16(O8w+(long)row*(2*DM)+ch*16,v);} }
  else
  { bf16*Ow=O+(rowbase+q0+w4*QBLK)*DM+h*D;
    bf16*stg=(bf16*)(shm+LDS_OST)+wid*2048;
    #pragma unroll
    for(int r=0;r<16;++r){const int orow=crow(r,hi);
      #pragma unroll
      for(int d0=0;d0<2;++d0)stg[orow*64+d0*32+r32]=__float2bfloat16(o[d0][r]*rli[r]);}
    asm volatile("s_waitcnt lgkmcnt(0)":::"memory");
    #pragma unroll
    for(int i=0;i<4;++i){const int row=i*8+(lane>>3),ch=lane&7; const u32x4 v=*(const u32x4*)(stg+row*64+ch*8); ATTN_STORE16(Ow+(long)row*DM+ch*8,v);} }
  asm volatile("s_waitcnt lgkmcnt(0)\n\ts_barrier":::"memory");
  #undef DMA_K
  #undef DMA_V
  #undef CMASK
  #undef START
  #undef RESC
  #undef ROT
}
constexpr int ATTN_LDS_BYTES=LDS_BYTES;
struct AttnTensors { const bf16* Q; const bf16* K; const bf16* V; bf16* O; unsigned char* O8; };
template<int THRL=8> __device__ __forceinline__ void attn_phase(char*lds,const AttnTensors&T,int vcu,int nwg,lds_cfptr tab){
  const int per=(BATCH*(NHEAD/2)*(SEQ/QB))/nwg;
  for(int i=0;i<per;++i){ const int u=vcu*per+i, bhp=u/(SEQ/QB), g=u%(SEQ/QB); attn_unit<THRL>(bhp/(NHEAD/2),(bhp%(NHEAD/2))*2,g*2,T.Q,T.K,T.V,T.O,T.O8,lds,tab); }
}
#undef SBAR
#undef WAIT_BAR
}
static_assert(fa::DM == LDA && fa::ATTN_LDS_BYTES <= ATTN_TAB_OFF, "attention body geometry");
struct Args { const float* in[26]; float* out; unsigned char* ws; int ph_lo, ph_hi; };
struct Frame {
    LAS unsigned char* lds; int tid, lane, wave, G;
    int cvG, cvId;
    float* out; unsigned char* ws; unsigned* ctl;
    unsigned zoff;
    __device__ __forceinline__ const float* inp(int i) const { unsigned zo = zoff; asm volatile("" : "+s"(zo));
        const LAS unsigned* p = (const LAS unsigned*)(lds + LDSCTL_OFF + 256 + 8 * i + zo);
        const unsigned lo = __builtin_amdgcn_readfirstlane(p[0]), hi = __builtin_amdgcn_readfirstlane(p[1]); return (const float*)(const GAS float*)(((unsigned long long)hi << 32) | lo); }
    __device__ __forceinline__ void rethread() { int t = threadIdx.x; asm volatile("" : "+v"(t)); tid = t; lane = t & 63; wave = __builtin_amdgcn_readfirstlane(t >> 6);
        unsigned wl = __builtin_amdgcn_readfirstlane((unsigned)(unsigned long long)ws), wh = __builtin_amdgcn_readfirstlane((unsigned)((unsigned long long)ws >> 32));
        unsigned ol = __builtin_amdgcn_readfirstlane((unsigned)(unsigned long long)out), oh = __builtin_amdgcn_readfirstlane((unsigned)((unsigned long long)out >> 32));
        unsigned z = 0u;
        asm volatile("" : "+s"(wl), "+s"(wh), "+s"(ol), "+s"(oh), "+s"(z)); zoff = z;
        ws = (unsigned char*)(GAS unsigned char*)(((unsigned long long)wh << 32) | wl); out = (float*)(GAS float*)(((unsigned long long)oh << 32) | ol); ctl = (unsigned*)ws; }
};
enum { I_X = 0, I_MIXG, I_WIN, I_BGATE, I_DWW, I_DWB, I_CLNG, I_CLNB, I_COUTW, I_SLNG, I_SLNB, I_SWS, I_SBS, I_SOUTW, I_RELB, I_AOUTW, I_WOUT, I_FFNG, I_FWG, I_FWU, I_FWD, I_ROUTER, I_MWG, I_MWU, I_MWD, I_FING };

struct DstPlain { int off; __device__ __forceinline__ int operator()(int n) const { return n + off; } };
struct DstGU { int half; __device__ __forceinline__ int operator()(int n) const { return (n >> 7) * 256 + (n & 127) + half * 128; } };
template <int Q, class DstOf>
__device__ __forceinline__ void cvt_matrix_t(const Frame& F, const float* src, int ld_src, int N, int K, void* dstv, const DstOf drow, float scale, int& tbase, const float* ks = nullptr) {
    constexpr bool F8 = Q != 0; constexpr int P = F8 ? 136 : 264;
    LAS unsigned char* T = (LAS unsigned char*)F.lds;
    const int nkb = K >> 7, ntiles = (N >> 6) * nkb;
    int first = F.cvId - (tbase % F.cvG); if (first < 0) first += F.cvG;
    const int nq = F.tid & 15, kq = F.tid >> 4;
    f32x4 v[4], kg = (f32x4){1.f, 1.f, 1.f, 1.f};
    if (first < ntiles) { const int nb = first / nkb, kb = first - nb * nkb; const float* sp = src + nb * 64 + (size_t)(kb * 128) * ld_src;
#pragma unroll
        for (int i = 0; i < 4; ++i) v[i] = *(const f32x4*)(sp + (size_t)(kq * 4 + i) * ld_src + nq * 4);
        if (ks) kg = *(const f32x4*)(ks + kb * 128 + kq * 4); }
    for (int id = first; id < ntiles; id += F.cvG) {
        const int nb = id / nkb, kb = id - nb * nkb, n0 = nb * 64, k0 = kb * 128;
        const int d0 = drow(n0);
        const f32x4 sk = kg * scale;
#pragma unroll
        for (int j = 0; j < 4; ++j) {
            const float x0 = v[0][j] * sk[0], x1 = v[1][j] * sk[1], x2 = v[2][j] * sk[2], x3 = v[3][j] * sk[3];
            if (F8) *(LAS unsigned*)(T + (nq * 4 + j) * P + kq * 4) = (Q == 2) ? cvt4_i8(x0, x1, x2, x3) : cvt4_fp8(x0, x1, x2, x3);
            else { u32x2 w; w.x = cvt_pk_bf16(x0, x1); w.y = cvt_pk_bf16(x2, x3); *(LAS u32x2*)(T + (nq * 4 + j) * P + kq * 8) = w; }
        }
        const int nid = id + F.cvG;
        if (nid < ntiles) { const int nb2 = nid / nkb, kb2 = nid - nb2 * nkb; const float* sp = src + nb2 * 64 + (size_t)(kb2 * 128) * ld_src;
#pragma unroll
            for (int i = 0; i < 4; ++i) v[i] = *(const f32x4*)(sp + (size_t)(kq * 4 + i) * ld_src + nq * 4);
            if (ks) kg = *(const f32x4*)(ks + kb2 * 128 + kq * 4); }
        __syncthreads();
        if (F8) { const int n = F.tid >> 3, kc = F.tid & 7;
            const u32x2 w0 = *(const LAS u32x2*)(T + n * P + kc * 16), w1 = *(const LAS u32x2*)(T + n * P + kc * 16 + 8);
            u32x4 w; w.x = w0.x; w.y = w0.y; w.z = w1.x; w.w = w1.y;
            *(u32x4*)((unsigned char*)dstv + (size_t)(d0 + n) * K + k0 + kc * 16) = w;
        } else {
#pragma unroll
            for (int p = 0; p < 2; ++p) { const int n = p * 32 + (F.tid >> 4), kc = F.tid & 15;
                const u32x2 w0 = *(const LAS u32x2*)(T + n * P + kc * 16), w1 = *(const LAS u32x2*)(T + n * P + kc * 16 + 8);
                u32x4 w; w.x = w0.x; w.y = w0.y; w.z = w1.x; w.w = w1.y;
                *(u32x4*)((bf16*)dstv + (size_t)(d0 + n) * K + k0 + kc * 8) = w; }
        }
        __syncthreads();
    }
    tbase += ntiles;
}
template <class DstOf>
__device__ __forceinline__ void cvt_matrix(const Frame& F, const float* src, int ld_src, int N, int K, bf16* dst, const DstOf drow, int& tbase, const float* ks = nullptr) { cvt_matrix_t<0>(F, src, ld_src, N, K, dst, drow, 1.0f, tbase, ks); }
template <class DstOf>
__device__ __forceinline__ void cvt_matrix_f8(const Frame& F, const float* src, int ld_src, int N, int K, unsigned char* dst, const DstOf drow, float scale, int& tbase) { cvt_matrix_t<1>(F, src, ld_src, N, K, dst, drow, scale, tbase); }
template <class DstOf>
__device__ __forceinline__ void cvt_matrix_i8(const Frame& F, const float* src, int ld_src, int N, int K, unsigned char* dst, const DstOf drow, float scale, int& tbase) { cvt_matrix_t<2>(F, src, ld_src, N, K, dst, drow, scale, tbase); }
__device__ __forceinline__ void cvt_moe_layer(const Frame& F, int mi, int& tb, int e_lo, int e_hi) {
    for (int e = e_lo; e < e_hi; ++e) {
        const size_t so = ((size_t)mi * NEXP + e) * (size_t)DM * DFE;
        unsigned char* gu = F.ws + WS_MGU + ((size_t)mi * NEXP + e) * 2 * DFE * DM;
        if (I8_UP) { cvt_matrix_i8(F, F.inp(I_MWG) + so, DFE, DFE, DM, gu, DstGU{0}, I8_SW, tb); cvt_matrix_i8(F, F.inp(I_MWU) + so, DFE, DFE, DM, gu, DstGU{1}, I8_SW, tb); }
        else { cvt_matrix_f8(F, F.inp(I_MWG) + so, DFE, DFE, DM, gu, DstGU{0}, F8_SW, tb);
        cvt_matrix_f8(F, F.inp(I_MWU) + so, DFE, DFE, DM, gu, DstGU{1}, F8_SW, tb); }
        cvt_matrix_f8(F, F.inp(I_MWD) + so, DM, DM, DFE, F.ws + WS_MD + ((size_t)mi * NEXP + e) * DM * DFE, DstPlain{0}, F8_SW, tb);
    }
}
__device__ __forceinline__ void prologue_convert(const Frame& F) {
    int tb = 0;
    for (int l = 0; l < DEPTH; ++l) {
        const float* win = F.inp(I_WIN) + (size_t)l * DM * NIN;
        bf16* wm = (bf16*)(F.ws + WS_WIN) + (size_t)l * NMAIN * DM;
        if ((l >= F8_WIN_FROM || I8_WIN_ALL) && I8_WIN) {
            cvt_matrix_i8(F, win, NIN, 512, DM, (unsigned char*)wm, DstGU{0}, I8_SW, tb);
            cvt_matrix_i8(F, win + 512, NIN, 512, DM, (unsigned char*)wm, DstGU{1}, I8_SW, tb);
            cvt_matrix_i8(F, win + 1024, NIN, 2048, DM, (unsigned char*)wm, DstPlain{1024}, I8_SW, tb);
            cvt_matrix_i8(F, win + 3584, NIN, 3072, DM, (unsigned char*)wm, DstPlain{3072}, I8_SW, tb);
            cvt_matrix_i8(F, win + 3072, NIN, 512, DM, (unsigned char*)wm, DstPlain{6144}, I8_SW, tb);
        } else if (l >= F8_WIN_FROM) {
            cvt_matrix_f8(F, win, NIN, 512, DM, (unsigned char*)wm, DstGU{0}, F8_SW, tb);
            cvt_matrix_f8(F, win + 512, NIN, 512, DM, (unsigned char*)wm, DstGU{1}, F8_SW, tb);
            cvt_matrix_f8(F, win + 1024, NIN, 2048, DM, (unsigned char*)wm, DstPlain{1024}, F8_SW, tb);
            cvt_matrix_f8(F, win + 3584, NIN, 3072, DM, (unsigned char*)wm, DstPlain{3072}, F8_SW, tb);
            cvt_matrix_f8(F, win + 3072, NIN, 512, DM, (unsigned char*)wm, DstPlain{6144}, F8_SW, tb);
        } else {
        const float* mg = F.inp(I_MIXG) + l * DM;
        cvt_matrix(F, win, NIN, 512, DM, wm, DstGU{0}, tb, mg);
        cvt_matrix(F, win + 512, NIN, 512, DM, wm, DstGU{1}, tb, mg);
        cvt_matrix(F, win + 1024, NIN, 2048, DM, wm, DstPlain{1024}, tb, mg);
        if (l >= F8_GATE_FROM && I8_WIN) cvt_matrix_i8(F, win + 3584, NIN, 3072, DM, F.ws + WS_WG8 + (size_t)l * WS_WG8_STEP, DstPlain{0}, I8_SW, tb);
        else if (l >= F8_GATE_FROM) cvt_matrix_f8(F, win + 3584, NIN, 3072, DM, F.ws + WS_WG8 + (size_t)l * WS_WG8_STEP, DstPlain{0}, F8_SW, tb);
        else cvt_matrix(F, win + 3584, NIN, 3072, DM, wm, DstPlain{3072}, tb, mg);
        cvt_matrix(F, win + 3072, NIN, 512, DM, wm, DstPlain{6144}, tb, mg);
        }
        if (l >= F8_BR_FROM) { unsigned char* wb8 = (unsigned char*)((bf16*)(F.ws + WS_WBR) + (size_t)(l * 3) * DM * 512);
        cvt_matrix_t<1>(F, F.inp(I_COUTW) + (size_t)l * 512 * DM, DM, DM, 512, wb8, DstPlain{0}, F8_SW, tb);
        cvt_matrix_t<1>(F, F.inp(I_SOUTW) + (size_t)l * 512 * DM, DM, DM, 512, wb8 + (size_t)DM * 512, DstPlain{0}, F8_SW, tb);
        cvt_matrix_t<1>(F, F.inp(I_AOUTW) + (size_t)l * 512 * DM, DM, DM, 512, wb8 + (size_t)2 * DM * 512, DstPlain{0}, F8_SW, tb);
        } else {
        cvt_matrix_t<0>(F, F.inp(I_COUTW) + (size_t)l * 512 * DM, DM, DM, 512, (bf16*)(F.ws + WS_WBR) + (size_t)(l * 3 + 0) * DM * 512, DstPlain{0}, 1.0f / 256.0f, tb);
        cvt_matrix_t<0>(F, F.inp(I_SOUTW) + (size_t)l * 512 * DM, DM, DM, 512, (bf16*)(F.ws + WS_WBR) + (size_t)(l * 3 + 1) * DM * 512, DstPlain{0}, 1.0f / 256.0f, tb);
        cvt_matrix_t<0>(F, F.inp(I_AOUTW) + (size_t)l * 512 * DM, DM, DM, 512, (bf16*)(F.ws + WS_WBR) + (size_t)(l * 3 + 2) * DM * 512, DstPlain{0}, 1.0f / 256.0f, tb); }
        if (l >= I8_WOUT_FROM) cvt_matrix_i8(F, F.inp(I_WOUT) + (size_t)l * DM * DM, DM, DM, DM, (unsigned char*)((bf16*)(F.ws + WS_WO) + (size_t)l * DM * DM), DstPlain{0}, I8_SW, tb);
        else if (l >= F8_WOUT_FROM) cvt_matrix_f8(F, F.inp(I_WOUT) + (size_t)l * DM * DM, DM, DM, DM, (unsigned char*)((bf16*)(F.ws + WS_WO) + (size_t)l * DM * DM), DstPlain{0}, F8_SW, tb);
        else cvt_matrix(F, F.inp(I_WOUT) + (size_t)l * DM * DM, DM, DM, DM, (bf16*)(F.ws + WS_WO) + (size_t)l * DM * DM, DstPlain{0}, tb);
    }
    for (int i = 0; i < 2; ++i) {
        const size_t so = (size_t)i * DM * DFF;
        bf16* gu = (bf16*)(F.ws + WS_FGU) + (size_t)i * 2 * DFF * DM;
        if (I8_UP && (i != 0 || I8_UP_L0)) {
            cvt_matrix_i8(F, F.inp(I_FWG) + so, DFF, DFF, DM, (unsigned char*)gu, DstGU{0}, I8_SW, tb);
            cvt_matrix_i8(F, F.inp(I_FWU) + so, DFF, DFF, DM, (unsigned char*)gu, DstGU{1}, I8_SW, tb);
            if (2 * i == F8_DENSE_LAYER) cvt_matrix_f8(F, F.inp(I_FWD) + so, DM, DM, DFF, (unsigned char*)((bf16*)(F.ws + WS_FD) + (size_t)i * DM * DFF), DstPlain{0}, F8_SW, tb);
            else cvt_matrix(F, F.inp(I_FWD) + so, DM, DM, DFF, (bf16*)(F.ws + WS_FD) + (size_t)i * DM * DFF, DstPlain{0}, tb);
        } else if (2 * i == F8_DENSE_LAYER) {
            cvt_matrix_f8(F, F.inp(I_FWG) + so, DFF, DFF, DM, (unsigned char*)gu, DstGU{0}, F8_SW, tb);
            cvt_matrix_f8(F, F.inp(I_FWU) + so, DFF, DFF, DM, (unsigned char*)gu, DstGU{1}, F8_SW, tb);
            cvt_matrix_f8(F, F.inp(I_FWD) + so, DM, DM, DFF, (unsigned char*)((bf16*)(F.ws + WS_FD) + (size_t)i * DM * DFF), DstPlain{0}, F8_SW, tb);
        } else {
        const float* fg = F.inp(I_FFNG) + (2 * i) * DM;
        cvt_matrix(F, F.inp(I_FWG) + so, DFF, DFF, DM, gu, DstGU{0}, tb, fg);
        cvt_matrix(F, F.inp(I_FWU) + so, DFF, DFF, DM, gu, DstGU{1}, tb, fg);
        cvt_matrix(F, F.inp(I_FWD) + so, DM, DM, DFF, (bf16*)(F.ws + WS_FD) + (size_t)i * DM * DFF, DstPlain{0}, tb);
        }
    }
    cvt_moe_layer(F, 0, tb, 0, NEXP);
    cvt_moe_layer(F, 1, tb, F.G > TAIL_WG0 ? MOE1_TAIL_EXPERTS : 0, NEXP);
    { const float* s = F.inp(I_SWS); bf16* d = (bf16*)(F.ws + WS_SGUW); const int n4 = DEPTH * 4 * 128 * 128 / 4;
      for (int i = blockIdx.x * 512 + F.tid; i < n4; i += F.G * 512) { const f32x4 v = *(const f32x4*)(s + (size_t)i * 4); u32x2 w; w.x = cvt_pk_bf16(v[0], v[1]); w.y = cvt_pk_bf16(v[2], v[3]); *(u32x2*)(d + (size_t)i * 4) = w; } }
}

__device__ __forceinline__ void hinit_phase(const Frame& F, const float* src, bf16* hb, unsigned char* x8, const float* gain) {
    const int lane = F.lane, rows_per_wg = NTOK / F.G, rpw = rows_per_wg / 8;
    float* part = (float*)(F.ws + WS_PART);
    const size_t tb = (size_t)blockIdx.x * rows_per_wg + (size_t)F.wave * rpw;
    f32x4 g8v[4];
#pragma unroll
    for (int i = 0; i < 4; ++i) g8v[i] = x8 ? *(const f32x4*)(gain + i * 256 + lane * 4) * (I8_WIN ? I8_SXN : F8_SX) : (f32x4){0.f, 0.f, 0.f, 0.f};
    for (int r0 = 0; r0 < rpw; r0 += 4) {
        f32x4 v[4][4];
#pragma unroll
        for (int r = 0; r < 4; ++r)
#pragma unroll
            for (int i = 0; i < 4; ++i) v[r][i] = *(const f32x4*)(src + (tb + r0 + r) * DM + i * 256 + lane * 4);
#pragma unroll
        for (int r = 0; r < 4; ++r) { const size_t t = tb + r0 + r; float ss = 0.f;
#pragma unroll
            for (int i = 0; i < 4; ++i) { const f32x4 x = v[r][i]; ss += (x[0] * x[0] + x[1] * x[1]) + (x[2] * x[2] + x[3] * x[3]);
                u32x2 w; w.x = cvt_pk_bf16(x[0], x[1]); w.y = cvt_pk_bf16(x[2], x[3]); *(u32x2*)(hb + t * DM + i * 256 + lane * 4) = w;
                if (x8) { const f32x4 xs_ = x * g8v[i]; *(unsigned*)(x8 + t * DM + i * 256 + lane * 4) = I8_WIN ? cvt4_i8(xs_[0], xs_[1], xs_[2], xs_[3]) : cvt4_fp8(xs_[0], xs_[1], xs_[2], xs_[3]); } }
            ss = wave_sum(ss);
            if (lane < 16) part[t * 16 + lane] = lane == 0 ? ss : 0.f; }
    }
}
template <bool FINAL>
__device__ __forceinline__ void combine_norm_phase(const Frame& F, bf16* h, const float* gain, unsigned char* xf8, float* outf) {
    const int lane = F.lane, rows_per_wg = NTOK / F.G, rpw = rows_per_wg / 8;
    const unsigned* route = (const unsigned*)(F.ws + WS_ROUTE);
    const bf16* y = (const bf16*)(F.ws + WS_Y);
    f32x4 gv[4];
#pragma unroll
    for (int i = 0; i < 4; ++i) gv[i] = *(const f32x4*)(gain + i * 256 + lane * 4);
    const size_t tb = (size_t)blockIdx.x * rows_per_wg + (size_t)F.wave * rpw;
    u32x4 rr = (u32x4){0u, 0u, 0u, 0u};
    if (lane < rpw) rr = *(const u32x4*)(route + (tb + lane) * 8 + 4);
    u32x2 hc[4], ya[4], yb[4];
    { const size_t s0 = (unsigned)__builtin_amdgcn_readlane((int)rr.z, 0), s1 = (unsigned)__builtin_amdgcn_readlane((int)rr.w, 0);
#pragma unroll
      for (int i = 0; i < 4; ++i) { hc[i] = *(const u32x2*)(h + tb * DM + i * 256 + lane * 4); ya[i] = *(const u32x2*)(y + s0 * DM + i * 256 + lane * 4); yb[i] = *(const u32x2*)(y + s1 * DM + i * 256 + lane * 4); } }
    for (int ri = 0; ri < rpw; ++ri) {
        const size_t t = tb + ri;
        u32x2 hn[4], na[4], nb[4];
        { const int rn = ri + 1 < rpw ? ri + 1 : ri;
          const size_t s0 = (unsigned)__builtin_amdgcn_readlane((int)rr.z, rn), s1 = (unsigned)__builtin_amdgcn_readlane((int)rr.w, rn);
#pragma unroll
          for (int i = 0; i < 4; ++i) { hn[i] = *(const u32x2*)(h + (tb + rn) * DM + i * 256 + lane * 4); na[i] = *(const u32x2*)(y + s0 * DM + i * 256 + lane * 4); nb[i] = *(const u32x2*)(y + s1 * DM + i * 256 + lane * 4); } }
        const float w0 = __uint_as_float((unsigned)__builtin_amdgcn_readlane((int)rr.x, ri)), w1 = __uint_as_float((unsigned)__builtin_amdgcn_readlane((int)rr.y, ri));
        f32x4 v[4];
#pragma unroll
        for (int i = 0; i < 4; ++i) {
            v[i][0] = bflo(hc[i].x) + (w0 * bflo(ya[i].x) + w1 * bflo(yb[i].x)); v[i][1] = bfhi(hc[i].x) + (w0 * bfhi(ya[i].x) + w1 * bfhi(yb[i].x));
            v[i][2] = bflo(hc[i].y) + (w0 * bflo(ya[i].y) + w1 * bflo(yb[i].y)); v[i][3] = bfhi(hc[i].y) + (w0 * bfhi(ya[i].y) + w1 * bfhi(yb[i].y)); }
        if (!FINAL) {
#pragma unroll
            for (int i = 0; i < 4; ++i) { u32x2 w; w.x = cvt_pk_bf16(v[i][0], v[i][1]); w.y = cvt_pk_bf16(v[i][2], v[i][3]); *(u32x2*)(h + t * DM + i * 256 + lane * 4) = w; }
        }
        float ss = 0.f;
#pragma unroll
        for (int i = 0; i < 4; ++i) ss += (v[i][0] * v[i][0] + v[i][1] * v[i][1]) + (v[i][2] * v[i][2] + v[i][3] * v[i][3]);
        ss = wave_sum(ss);
        const float rstd = __builtin_amdgcn_rsqf(ss * (1.0f / DM) + EPS);
#pragma unroll
        for (int i = 0; i < 4; ++i) v[i] = v[i] * rstd * gv[i];
        if (FINAL) {
#pragma unroll
            for (int i = 0; i < 4; ++i) *(f32x4*)(outf + t * DM + i * 256 + lane * 4) = v[i];
        } else {
#pragma unroll
            for (int i = 0; i < 4; ++i) *(unsigned*)(xf8 + t * DM + i * 256 + lane * 4) = I8_WIN ? cvt4_i8(v[i][0] * I8_SXN, v[i][1] * I8_SXN, v[i][2] * I8_SXN, v[i][3] * I8_SXN)
                                                                                                 : cvt4_fp8(v[i][0] * F8_SX, v[i][1] * F8_SX, v[i][2] * F8_SX, v[i][3] * F8_SX);
        }
#pragma unroll
        for (int i = 0; i < 4; ++i) { hc[i] = hn[i]; ya[i] = na[i]; yb[i] = nb[i]; }
    }
}
constexpr unsigned SLOT_MAIN = 65536u;
template <int MODE>
__device__ __forceinline__ void combine_final_rows(const Frame& F, const bf16* h, const float* gain, float* outf, size_t row0, int nrows) {
    const int lane = F.lane;
    if (nrows <= 0) return;
    const unsigned* route = (const unsigned*)(F.ws + WS_ROUTE);
    const bf16* y = (const bf16*)(F.ws + WS_Y);
    f32x4 gv[4];
#pragma unroll
    for (int i = 0; i < 4; ++i) gv[i] = *(const f32x4*)(gain + i * 256 + lane * 4);
    u32x4 rr = (u32x4){0u, 0u, 0u, 0u};
    if (lane < nrows) rr = *(const u32x4*)(route + (row0 + lane) * 8 + 4);
    u32x2 hc[4], ya[4], yb[4];
    if (MODE == 1) { const size_t s0 = (unsigned)__builtin_amdgcn_readlane((int)rr.z, 0), s1 = (unsigned)__builtin_amdgcn_readlane((int)rr.w, 0);
#pragma unroll
      for (int i = 0; i < 4; ++i) { hc[i] = *(const u32x2*)(h + row0 * DM + i * 256 + lane * 4); ya[i] = *(const u32x2*)(y + s0 * DM + i * 256 + lane * 4); yb[i] = *(const u32x2*)(y + s1 * DM + i * 256 + lane * 4); } }
    for (int ri = 0; ri < nrows; ++ri) {
        const size_t t = row0 + ri;
        const unsigned c0 = (unsigned)__builtin_amdgcn_readlane((int)rr.z, ri), c1 = (unsigned)__builtin_amdgcn_readlane((int)rr.w, ri);
        const bool ready = (c0 < SLOT_MAIN) && (c1 < SLOT_MAIN);
        u32x2 hn[4], na[4], nb[4];
        if (MODE == 1) { const int rn = ri + 1 < nrows ? ri + 1 : ri;
          const size_t s0 = (unsigned)__builtin_amdgcn_readlane((int)rr.z, rn), s1 = (unsigned)__builtin_amdgcn_readlane((int)rr.w, rn);
#pragma unroll
          for (int i = 0; i < 4; ++i) { hn[i] = *(const u32x2*)(h + (row0 + rn) * DM + i * 256 + lane * 4); na[i] = *(const u32x2*)(y + s0 * DM + i * 256 + lane * 4); nb[i] = *(const u32x2*)(y + s1 * DM + i * 256 + lane * 4); } }
        else if (!ready) {
#pragma unroll
          for (int i = 0; i < 4; ++i) { hc[i] = *(const u32x2*)(h + t * DM + i * 256 + lane * 4); ya[i] = *(const u32x2*)(y + (size_t)c0 * DM + i * 256 + lane * 4); yb[i] = *(const u32x2*)(y + (size_t)c1 * DM + i * 256 + lane * 4); } }
        if ((MODE == 1) == ready) {
            const float w0 = __uint_as_float((unsigned)__builtin_amdgcn_readlane((int)rr.x, ri)), w1 = __uint_as_float((unsigned)__builtin_amdgcn_readlane((int)rr.y, ri));
            f32x4 v[4];
#pragma unroll
            for (int i = 0; i < 4; ++i) {
                v[i][0] = bflo(hc[i].x) + (w0 * bflo(ya[i].x) + w1 * bflo(yb[i].x)); v[i][1] = bfhi(hc[i].x) + (w0 * bfhi(ya[i].x) + w1 * bfhi(yb[i].x));
                v[i][2] = bflo(hc[i].y) + (w0 * bflo(ya[i].y) + w1 * bflo(yb[i].y)); v[i][3] = bfhi(hc[i].y) + (w0 * bfhi(ya[i].y) + w1 * bfhi(yb[i].y)); }
            float ss = 0.f;
#pragma unroll
            for (int i = 0; i < 4; ++i) ss += (v[i][0] * v[i][0] + v[i][1] * v[i][1]) + (v[i][2] * v[i][2] + v[i][3] * v[i][3]);
            ss = wave_sum(ss);
            const float rstd = __builtin_amdgcn_rsqf(ss * (1.0f / DM) + EPS);
#pragma unroll
            for (int i = 0; i < 4; ++i) *(f32x4*)(outf + t * DM + i * 256 + lane * 4) = v[i] * rstd * gv[i];
        }
        if (MODE == 1) {
#pragma unroll
            for (int i = 0; i < 4; ++i) { hc[i] = hn[i]; ya[i] = na[i]; yb[i] = nb[i]; } }
    }
}
__device__ __forceinline__ void route_permute_phase(const Frame& F, const bf16* src, const float* gain, int moe_idx) {
    const int lane = F.lane, rows_per_wg = NTOK / F.G, rpw = rows_per_wg / 8;
    unsigned* route = (unsigned*)(F.ws + WS_ROUTE);
    unsigned char* xs = F.ws + WS_Y;
    LAS unsigned char* R8 = (LAS unsigned char*)F.lds;
    LAS int* lcnt = (LAS int*)(F.lds + 131072);
    LAS unsigned* ltmp = (LAS unsigned*)(F.lds + 131072 + 128);
    LAS unsigned* ltab = (LAS unsigned*)(F.lds + 131072 + 4096);
    unsigned* tab = F.ctl + CW_TAB + moe_idx * 2048; unsigned* arr = F.ctl + CW_ARR + moe_idx * 64;
    f32x4 gv[4];
#pragma unroll
    for (int i = 0; i < 4; ++i) gv[i] = *(const f32x4*)(gain + i * 256 + lane * 4);
    f32x4 rw[16][2];
    { const float* R = F.inp(I_ROUTER) + (size_t)moe_idx * DM * NEXP;
#pragma unroll
      for (int i = 0; i < 4; ++i)
#pragma unroll
        for (int j = 0; j < 4; ++j) { const int k = i * 256 + lane * 4 + j; rw[i * 4 + j][0] = *(const f32x4*)(R + k * 8); rw[i * 4 + j][1] = *(const f32x4*)(R + k * 8 + 4); } }
    if (F.tid < 32) lcnt[F.tid] = 0;
    __syncthreads();
    u32x2 pc[4];
#pragma unroll
    for (int i = 0; i < 4; ++i) pc[i] = *(const u32x2*)(src + ((size_t)blockIdx.x * rows_per_wg + F.wave * rpw) * DM + i * 256 + lane * 4);
    for (int ri = 0; ri < rpw; ++ri) {
        const int lr = F.wave * rpw + ri;
        const size_t t = (size_t)blockIdx.x * rows_per_wg + lr;
        u32x2 pn[4];
        { const size_t tn = t + (ri + 1 < rpw ? 1 : 0);
#pragma unroll
          for (int i = 0; i < 4; ++i) pn[i] = *(const u32x2*)(src + tn * DM + i * 256 + lane * 4); }
        f32x4 v[4];
#pragma unroll
        for (int i = 0; i < 4; ++i) v[i] = (f32x4){bflo(pc[i].x), bfhi(pc[i].x), bflo(pc[i].y), bfhi(pc[i].y)};
        float ss = 0.f;
#pragma unroll
        for (int i = 0; i < 4; ++i) ss += (v[i][0] * v[i][0] + v[i][1] * v[i][1]) + (v[i][2] * v[i][2] + v[i][3] * v[i][3]);
        ss = wave_sum(ss);
        const float rstd = __builtin_amdgcn_rsqf(ss * (1.0f / DM) + EPS);
#pragma unroll
        for (int i = 0; i < 4; ++i) { v[i] = v[i] * rstd * gv[i];
            *(LAS unsigned*)(R8 + lr * 1024 + i * 256 + lane * 4) = I8_UP ? cvt4_i8(v[i][0] * I8_SXN, v[i][1] * I8_SXN, v[i][2] * I8_SXN, v[i][3] * I8_SXN) : cvt4_fp8(v[i][0] * F8_SX, v[i][1] * F8_SX, v[i][2] * F8_SX, v[i][3] * F8_SX); }
#pragma unroll
        for (int i = 0; i < 4; ++i) pc[i] = pn[i];
        float lg[8];
#pragma unroll
        for (int e = 0; e < 8; ++e) lg[e] = 0.f;
#pragma unroll
        for (int i = 0; i < 4; ++i)
#pragma unroll
            for (int j = 0; j < 4; ++j) { const float x = v[i][j];
#pragma unroll
                for (int e = 0; e < 4; ++e) { lg[e] += x * rw[i * 4 + j][0][e]; lg[4 + e] += x * rw[i * 4 + j][1][e]; } }
#pragma unroll
        for (int e = 0; e < 8; ++e) lg[e] = wave_sum(lg[e]);
        int e0 = 0; float v0 = lg[0];
#pragma unroll
        for (int e = 1; e < 8; ++e) if (lg[e] > v0) { v0 = lg[e]; e0 = e; }
        int e1 = -1; float v1 = -3.0e38f;
#pragma unroll
        for (int e = 0; e < 8; ++e) if (e != e0 && lg[e] > v1) { v1 = lg[e]; e1 = e; }
        const float ex = __expf(v1 - v0), w0 = __builtin_amdgcn_rcpf(1.0f + ex), w1 = ex * w0;
        if (lane == 0) {
            const int p0 = __hip_atomic_fetch_add(&lcnt[e0], 1, __ATOMIC_RELAXED, __HIP_MEMORY_SCOPE_WORKGROUP), p1 = __hip_atomic_fetch_add(&lcnt[e1], 1, __ATOMIC_RELAXED, __HIP_MEMORY_SCOPE_WORKGROUP);
            LAS unsigned* q = ltmp + lr * 6; q[0] = (unsigned)e0; q[1] = (unsigned)e1; q[2] = (unsigned)p0; q[3] = (unsigned)p1; q[4] = __float_as_uint(w0); q[5] = __float_as_uint(w1);
        }
    }
    __syncthreads();
    if (F.wave == 0) {
        if (lane < 8) { __hip_atomic_store(tab + blockIdx.x * 8 + lane, (unsigned)lcnt[lane], __ATOMIC_RELAXED, __HIP_MEMORY_SCOPE_AGENT);
                        (void)__hip_atomic_fetch_add(F.ctl + CW_CNT + moe_idx * 64 + lane, (unsigned)lcnt[lane], __ATOMIC_RELAXED, __HIP_MEMORY_SCOPE_AGENT); }
        asm volatile("s_waitcnt vmcnt(0)" ::: "memory");
        if (lane == 0) (void)__hip_atomic_fetch_add(arr, 1u, __ATOMIC_RELAXED, __HIP_MEMORY_SCOPE_AGENT);
        unsigned sp = 0;
        while ((unsigned)__builtin_amdgcn_readfirstlane((int)__hip_atomic_load(arr, __ATOMIC_RELAXED, __HIP_MEMORY_SCOPE_AGENT)) < (unsigned)F.G) { __builtin_amdgcn_s_sleep(2); if (++sp > (1u << 22)) break; }
        __builtin_amdgcn_fence(__ATOMIC_ACQUIRE, "agent");
        asm volatile("s_waitcnt vmcnt(0)" ::: "memory");
    }
    __syncthreads();
    for (int i = F.tid; i < F.G * 8; i += 512) ltab[i] = __hip_atomic_load(tab + i, __ATOMIC_RELAXED, __HIP_MEMORY_SCOPE_AGENT);
    __syncthreads();
    if (F.tid < 8) { int tot = 0, base = 0;
        for (int w = 0; w < F.G; ++w) { const int c = (int)ltab[w * 8 + F.tid]; base += (w < (int)blockIdx.x) ? c : 0; tot += c; }
        lcnt[8 + F.tid] = base; lcnt[24 + F.tid] = tot; }
    __syncthreads();
    if (F.tid == 0) { int sacc = 0;
#pragma unroll
        for (int e = 0; e < 8; ++e) { lcnt[16 + e] = sacc; sacc += (lcnt[24 + e] + 255) >> 8; } }
    __syncthreads();
    for (int ri = 0; ri < rpw; ++ri) {
        const int lr = F.wave * rpw + ri;
        const size_t t = (size_t)blockIdx.x * rows_per_wg + lr;
        const LAS unsigned* q = ltmp + lr * 6;
        const unsigned e0 = q[0], e1 = q[1];
        const size_t s0 = (size_t)lcnt[16 + e0] * 256 + (size_t)lcnt[8 + e0] + q[2], s1 = (size_t)lcnt[16 + e1] * 256 + (size_t)lcnt[8 + e1] + q[3];
        const u32x4 o = *(const LAS u32x4*)(R8 + lr * 1024 + lane * 16);
        *(u32x4*)(xs + s0 * DM + lane * 16) = o; *(u32x4*)(xs + s1 * DM + lane * 16) = o;
        if (lane == 0) { u32x4 r0; r0.x = e0; r0.y = e1; r0.z = q[2]; r0.w = q[3]; u32x4 r1; r1.x = q[4]; r1.y = q[5]; r1.z = (unsigned)s0; r1.w = (unsigned)s1;
            *(u32x4*)(route + t * 8) = r0; *(u32x4*)(route + t * 8 + 4) = r1; }
    }
    __syncthreads();
}
__device__ __forceinline__ void moe_tile_prefix(const Frame& F, int moe_idx, int (&tp)[9]) {
    int s = 0;
#pragma unroll
    for (int e = 0; e < 8; ++e) { tp[e] = s; const unsigned c = (unsigned)__builtin_amdgcn_readfirstlane((int)__hip_atomic_load(F.ctl + CW_CNT + moe_idx * 64 + e, __ATOMIC_RELAXED, __HIP_MEMORY_SCOPE_AGENT)); s += (int)((c + 255u) >> 8); }
    tp[8] = s;
}
__device__ __forceinline__ void conv_phase(const Frame& F, int layer, int f8out) {
    bf16* a = (bf16*)(F.ws + WS_BIG);
    LAS unsigned* L = (LAS unsigned*)F.lds;
    const float* dww = F.inp(I_DWW) + (size_t)layer * 31 * 512; const float* dwb = F.inp(I_DWB) + layer * 512;
    const float* lng = F.inp(I_CLNG) + layer * 512; const float* lnb = F.inp(I_CLNB) + layer * 512;
    const int cp = F.tid & 255, th = F.tid >> 8;
    f32x2 w[31];
#pragma unroll
    for (int k = 0; k < 31; ++k) w[k] = *(const f32x2*)(dww + k * 512 + cp * 2);
    const f32x2 bias = *(const f32x2*)(dwb + cp * 2);
    for (int u = blockIdx.x; u < NTOK / 64; u += F.G) {
        const int t0 = u * 64, pos0 = t0 & (SEQ - 1);
        { u32x4 o[12];
#pragma unroll
          for (int i = 0; i < 12; ++i) { const int id = F.tid + i * 512, j = id >> 6, ch = (id & 63) * 8; o[i] = (u32x4){0u, 0u, 0u, 0u};
              if (id < 94 * 64 && pos0 - 30 + j >= 0) o[i] = *(const u32x4*)(a + (size_t)(t0 - 30 + j) * LDA + A_CONV + ch); }
#pragma unroll
          for (int i = 0; i < 12; ++i) { const int id = F.tid + i * 512, j = id >> 6, ch = (id & 63) * 8;
              if (id < 94 * 64) *(LAS u32x4*)(L + j * 256 + (ch >> 1)) = o[i]; } }
        __syncthreads();
        f32x2 acc[4][8];
#pragma unroll
        for (int tb = 0; tb < 4; ++tb) {
            f32x2 x[38];
#pragma unroll
            for (int j = 0; j < 38; ++j) { const unsigned p = L[(th * 32 + tb * 8 + j) * 256 + cp]; x[j] = (f32x2){bflo(p), bfhi(p)}; }
#pragma unroll
            for (int i = 0; i < 8; ++i) { f32x2 s = bias;
#pragma unroll
                for (int k = 0; k < 31; ++k) s += x[i + k] * w[k];
                acc[tb][i] = s; }
        }
        __syncthreads();
#pragma unroll
        for (int tb = 0; tb < 4; ++tb)
#pragma unroll
            for (int i = 0; i < 8; ++i) L[(th * 32 + tb * 8 + i) * 256 + cp] = cvt_pk_bf16(acc[tb][i].x, acc[tb][i].y);
        __syncthreads();
        {
            const int c0 = F.lane * 8;
            const f32x4 g0 = *(const f32x4*)(lng + c0), g1 = *(const f32x4*)(lng + c0 + 4), b0 = *(const f32x4*)(lnb + c0), b1 = *(const f32x4*)(lnb + c0 + 4);
            for (int i = 0; i < 8; ++i) {
                const int tl = F.wave * 8 + i;
                const u32x4 p = *(const LAS u32x4*)(L + tl * 256 + F.lane * 4);
                float x[8] = {bflo(p.x), bfhi(p.x), bflo(p.y), bfhi(p.y), bflo(p.z), bfhi(p.z), bflo(p.w), bfhi(p.w)};
                float s = 0.f;
#pragma unroll
                for (int j = 0; j < 8; ++j) s += x[j];
                const float mu = wave_sum(s) * (1.0f / 512.0f);
                float q = 0.f;
#pragma unroll
                for (int j = 0; j < 8; ++j) { x[j] -= mu; q += x[j] * x[j]; }
                const float rstd = __builtin_amdgcn_rsqf(wave_sum(q) * (1.0f / 512.0f) + EPS);
                float yv[8];
#pragma unroll
                for (int j = 0; j < 8; ++j) { const float gg = j < 4 ? g0[j] : g1[j - 4], bb = j < 4 ? b0[j] : b1[j - 4]; const float yy = x[j] * rstd * gg + bb; yv[j] = yy * fast_sigmoid(yy); }
                if (f8out) { u32x2 o8; o8.x = cvt4_fp8(yv[0] * F8_SX, yv[1] * F8_SX, yv[2] * F8_SX, yv[3] * F8_SX); o8.y = cvt4_fp8(yv[4] * F8_SX, yv[5] * F8_SX, yv[6] * F8_SX, yv[7] * F8_SX);
                    *(u32x2*)((unsigned char*)a + (size_t)(t0 + tl) * (LDA * 2) + A8_HC + c0) = o8; }
                else {
                u32x4 o; o.x = cvt_pk_bf16(yv[0], yv[1]); o.y = cvt_pk_bf16(yv[2], yv[3]); o.z = cvt_pk_bf16(yv[4], yv[5]); o.w = cvt_pk_bf16(yv[6], yv[7]);
                *(u32x4*)(a + (size_t)(t0 + tl) * LDA + A_HC + c0) = o; }
            }
        }
        __syncthreads();
    }
}

__device__ __forceinline__ void sgu_phase(const Frame& F, int layer, int ocol, int f8out) {
    bf16* a = (bf16*)(F.ws + WS_BIG);
    constexpr int VP = 520;
    LAS bf16* V = (LAS bf16*)F.lds;
    const bf16* W = (const bf16*)(F.ws + WS_SGUW) + (size_t)layer * 4 * 128 * 128;
    const float* bs = F.inp(I_SBS) + layer * 4 * 128;
    const float* lng = F.inp(I_SLNG) + layer * 512; const float* lnb = F.inp(I_SLNB) + layer * 512;
    const int lane = F.lane, fr = lane & 15, fq = lane >> 4;
    for (int u = blockIdx.x; u < NTOK / 128; u += F.G) {
        const size_t t0 = (size_t)u * 128;
        {
            const int c0 = lane * 8;
            const f32x4 g0 = *(const f32x4*)(lng + c0), g1 = *(const f32x4*)(lng + c0 + 4), b0 = *(const f32x4*)(lnb + c0), b1 = *(const f32x4*)(lnb + c0 + 4);
            u32x4 pv[16];
#pragma unroll
            for (int i = 0; i < 16; ++i) pv[i] = *(const u32x4*)(a + (t0 + F.wave * 16 + i) * LDA + A_SGU + 512 + c0);
#pragma unroll
            for (int i = 0; i < 16; ++i) {
                const int s = F.wave * 16 + i;
                const u32x4 p = pv[i];
                float x[8] = {bflo(p.x), bfhi(p.x), bflo(p.y), bfhi(p.y), bflo(p.z), bfhi(p.z), bflo(p.w), bfhi(p.w)};
                float sm = 0.f;
#pragma unroll
                for (int j = 0; j < 8; ++j) sm += x[j];
                const float mu = wave_sum(sm) * (1.0f / 512.0f);
                float q = 0.f;
#pragma unroll
                for (int j = 0; j < 8; ++j) { x[j] -= mu; q += x[j] * x[j]; }
                const float rstd = __builtin_amdgcn_rsqf(wave_sum(q) * (1.0f / 512.0f) + EPS);
                float yv[8];
#pragma unroll
                for (int j = 0; j < 8; ++j) { const float gg = j < 4 ? g0[j] : g1[j - 4], bb = j < 4 ? b0[j] : b1[j - 4]; yv[j] = x[j] * rstd * gg + bb; }
                u32x4 o; o.x = cvt_pk_bf16(yv[0], yv[1]); o.y = cvt_pk_bf16(yv[2], yv[3]); o.z = cvt_pk_bf16(yv[4], yv[5]); o.w = cvt_pk_bf16(yv[6], yv[7]);
                *(LAS u32x4*)(V + s * VP + c0) = o;
            }
        }
        __syncthreads();
        {
            const int g = F.wave >> 1, cb = g * 128 + (F.wave & 1) * 64;
            const bf16* Wg = W + (size_t)g * 128 * 128;
            f32x4 acc[8][4];
#pragma unroll
            for (int m = 0; m < 8; ++m)
#pragma unroll
                for (int n = 0; n < 4; ++n) acc[m][n] = (f32x4){0.f, 0.f, 0.f, 0.f};
#pragma unroll 1
            for (int ks = 0; ks < 4; ++ks) {
                bf16x8 bfr[4];
#pragma unroll
                for (int n = 0; n < 4; ++n) {
                    const LAS bf16* vp = V + (ks * 32 + fq * 8) * VP + cb + n * 16 + fr;
#pragma unroll
                    for (int j = 0; j < 8; ++j) bfr[n][j] = (short)vp[j * VP];
                }
#pragma unroll
                for (int m = 0; m < 8; ++m) {
                    if (ks >= 2 && m < 4) continue;
                    const bf16x8 afr = *(const bf16x8*)(Wg + (m * 16 + fr) * 128 + ks * 32 + fq * 8);
#pragma unroll
                    for (int n = 0; n < 4; ++n) acc[m][n] = __builtin_amdgcn_mfma_f32_16x16x32_bf16(bfr[n], afr, acc[m][n], 0, 0, 0);
                }
            }
#pragma unroll
            for (int mh = 0; mh < 2; ++mh) {
            u32x2 uq[4][4]; float bq[4];
#pragma unroll
            for (int mm = 0; mm < 4; ++mm) { const int t = (mh * 4 + mm) * 16 + fr; bq[mm] = bs[g * 128 + t];
                const bf16* rp = a + (t0 + t) * LDA + A_SGU + cb + 4 * fq;
#pragma unroll
                for (int n = 0; n < 4; ++n) uq[mm][n] = *(const u32x2*)(rp + n * 16); }
#pragma unroll
            for (int mm = 0; mm < 4; ++mm) { const int m = mh * 4 + mm;
                const int t = m * 16 + fr; const float bb = bq[mm];
                bf16* wp = a + (t0 + t) * LDA + ocol + cb + 4 * fq;
                unsigned char* wp8 = (unsigned char*)a + (t0 + t) * (size_t)(LDA * 2) + A8_SGU + cb + 4 * fq;
#pragma unroll
                for (int n = 0; n < 4; ++n) { const u32x2 uu = uq[mm][n]; const f32x4 v = acc[m][n];
                    const float h0 = bflo(uu.x) * (v[0] + bb), h1 = bfhi(uu.x) * (v[1] + bb), h2 = bflo(uu.y) * (v[2] + bb), h3 = bfhi(uu.y) * (v[3] + bb);
                    if (f8out) *(unsigned*)(wp8 + n * 16) = cvt4_fp8(h0 * F8_SX, h1 * F8_SX, h2 * F8_SX, h3 * F8_SX);
                    else { u32x2 o; o.x = cvt_pk_bf16(h0, h1); o.y = cvt_pk_bf16(h2, h3); *(u32x2*)(wp + n * 16) = o; } }
            }
            }
        }
        __syncthreads();
    }
}

template <class Sched>
__device__ __forceinline__ pg8::RowScale build_row_scale(const Frame& F, const Sched& S, bool by_pn) {
    pg8::RowScale R; LAS float* tab = (LAS float*)(F.lds + LDS_ROWSCALE_OFF); const float* part = (const float*)(F.ws + WS_PART);
    R.tab = tab; R.part = part; R.p0 = -1; R.p1 = -1; R.p2 = -1; R.p3 = -1; int ns = 0;
    pg8::Unit u;
    for (int i = 0; S.next(i, u); ++i) {
        const int p = by_pn ? u.pn : u.pm;
        if (p == R.p0 || p == R.p1 || p == R.p2 || p == R.p3 || ns >= 4) continue;
        if (ns == 0) R.p0 = p; else if (ns == 1) R.p1 = p; else if (ns == 2) R.p2 = p; else R.p3 = p;
        ++ns;
    }
    {
        const int hs = F.tid >> 8, rw = F.tid & 255;
        const int pa = hs ? R.p1 : R.p0, pb = hs ? R.p3 : R.p2;
        f32x4 qa[4], qb[4];
#pragma unroll
        for (int k = 0; k < 4; ++k) { qa[k] = (f32x4){0.f, 0.f, 0.f, 0.f}; qb[k] = (f32x4){0.f, 0.f, 0.f, 0.f}; }
        if (pa >= 0) { const float* pp = part + (size_t)(pa * 256 + rw) * 16;
#pragma unroll
            for (int k = 0; k < 4; ++k) qa[k] = *(const f32x4*)(pp + 4 * k); }
        if (pb >= 0) { const float* pp = part + (size_t)(pb * 256 + rw) * 16;
#pragma unroll
            for (int k = 0; k < 4; ++k) qb[k] = *(const f32x4*)(pp + 4 * k); }
        if (pa >= 0) { const float sm = (((qa[0][0] + qa[0][1]) + (qa[0][2] + qa[0][3])) + ((qa[1][0] + qa[1][1]) + (qa[1][2] + qa[1][3]))) + (((qa[2][0] + qa[2][1]) + (qa[2][2] + qa[2][3])) + ((qa[3][0] + qa[3][1]) + (qa[3][2] + qa[3][3])));
            tab[hs * 256 + rw] = __builtin_amdgcn_rsqf(sm * (1.0f / DM) + EPS); }
        if (pb >= 0) { const float sm = (((qb[0][0] + qb[0][1]) + (qb[0][2] + qb[0][3])) + ((qb[1][0] + qb[1][1]) + (qb[1][2] + qb[1][3]))) + (((qb[2][0] + qb[2][1]) + (qb[2][2] + qb[2][3])) + ((qb[3][0] + qb[3][1]) + (qb[3][2] + qb[3][3])));
            tab[(2 + hs) * 256 + rw] = __builtin_amdgcn_rsqf(sm * (1.0f / DM) + EPS); }
    }
    __syncthreads();
    return R;
}
__device__ __forceinline__ pg8::RowScale no_row_scale() { pg8::RowScale R; R.tab = nullptr; R.part = nullptr; R.p0 = -1; R.p1 = -1; R.p2 = -1; R.p3 = -1; return R; }

constexpr int PH_PER_LAYER = 9;
constexpr int N_PHASES = 1 + DEPTH * PH_PER_LAYER;

__global__ void __launch_bounds__(512, 2) trunk_fwd(Args args) {
    extern __shared__ __attribute__((aligned(16))) unsigned char lds_raw[];
    Frame F;
    F.lds = (LAS unsigned char*)lds_raw;
    F.out = args.out; F.ws = args.ws; F.ctl = (unsigned*)(args.ws + WS_CTL);
    F.rethread(); F.G = gridDim.x; F.cvG = F.G; F.cvId = (int)blockIdx.x;
    volatile LAS unsigned* MISC = (volatile LAS unsigned*)(F.lds + LDSCTL_OFF);
    if (F.tid < 64) MISC[F.tid] = 0u;
    if (F.tid == 0) {
#pragma unroll
        for (int i = 0; i < 26; ++i) *(LAS unsigned long long*)(F.lds + LDSCTL_OFF + 256 + 8 * i) = (unsigned long long)args.in[i]; }
    __syncthreads();
#if MK_MULTI
#define GRID_BAR() do { } while (0)
#else
    XcdBarrier bar = xcd_barrier_post(F.ctl + CW_BAR, MISC + 8);
#define GRID_BAR() do { XcdBarrier b_; b_.bar = (unsigned*)F.ws + CW_BAR; b_.x = xb_xcc_id(); b_.st = MISC + 8; xcd_barrier(b_); } while (0)
#endif
#if MK_MULTI
    const int lo = args.ph_lo, hi = args.ph_hi;
#else
    constexpr int lo = 0, hi = N_PHASES;
#endif
#define IN(k) (lo <= (k) && (k) < hi)
#define SEAM(k) do { if (IN(k) && IN((k) + 1)) GRID_BAR(); } while (0)

#define a     ((bf16*)(F.ws + WS_BIG))
#define hb    ((bf16*)(F.ws + WS_XN))
#define xf8   (F.ws + WS_XF8)
#define partb ((float*)(F.ws + WS_PART))
#define inter ((bf16*)(F.ws + WS_BIG))
#define ybuf  ((bf16*)(F.ws + WS_Y))

    if (IN(0)) {
        F.rethread();
#pragma unroll 1
        for (int rep = (PROBE & 1) ? 0 : 1; rep < 2; ++rep) { if (PHM(0)) prologue_convert(F); }
        if (PHM(1)) hinit_phase(F, F.inp(I_X), hb, F8_GATE_FROM == 0 ? xf8 : nullptr, F.inp(I_MIXG));
    }
    SEAM(0);

    for (int layer = 0; layer < DEPTH; ++layer) {
        const int pb = 1 + layer * PH_PER_LAYER;
        const bool moe = (layer & 1) != 0; const int fi = layer >> 1;

        if (IN(pb + 0)) {
#pragma unroll 1
          for (int rep = (PROBE & 16) ? 0 : 1; rep < 2; ++rep) {
            F.rethread();
            if (PHM(2) && layer >= F8_GATE_FROM && layer < F8_WIN_FROM && !I8_WIN_ALL) {
              LAS float* lb = (LAS float*)(F.lds + LDS_BIAS_OFF); const float* bg = F.inp(I_BGATE) + layer * 3 * DM;
              { pg8::SchedWin S; S.o.init(NTOK / 256, 14, F.G, (int)blockIdx.x); S.A = (const char*)hb; S.B = (const char*)(F.ws + WS_WIN) + (size_t)layer * NMAIN * DM * 2; S.tA = 256 * DM * 2; S.tB = 256 * DM * 2; S.nlo = 12; S.skip = 12; S.boff = 0;
                const pg8::RowScale RS = build_row_scale(F, S, false);
                pg8::EpiWin E{a, bg, lb, 1.0f, F.ws + WS_G8, RS};
                pg8::gemm_phase(F.lds, DM, DM * 2, DM * 2, S, E); }
              { F.rethread();
                pg8::SchedWin S; S.o.init(NTOK / 256, 12, F.G, (int)blockIdx.x); S.A = (const char*)xf8; S.B = (const char*)(F.ws + WS_WG8 + (size_t)layer * WS_WG8_STEP); S.tA = 256 * DM; S.tB = 256 * DM; S.nlo = 0; S.skip = 12; S.boff = 12;
                float bl[6];
#pragma unroll
                for (int k = 0; k < 6; ++k) bl[k] = bg[F.tid + k * 512];
                const pg8::RowScale RS = build_row_scale(F, S, false);
#pragma unroll
                for (int k = 0; k < 6; ++k) lb[F.tid + k * 512] = bl[k];
                __syncthreads();
                if (I8_WIN) { pg8::EpiWin E{a, bg, lb, 1.0f / (((layer & 1) ? i8_sxu(layer - 1) : I8_SXN) * I8_SW), F.ws + WS_G8, RS};
                    pg8::gemm_phase<pg8::EpiWin, pg8::SchedWin, false, true>(F.lds, DM / 2, DM, DM, S, E); }
                else { pg8::EpiWin E{a, bg, lb, 1.0f / (F8_SX * F8_SW), F.ws + WS_G8, RS};
                pg8::gemm_phase<pg8::EpiWin, pg8::SchedWin, true>(F.lds, DM / 2, DM, DM, S, E); } }
            } else
            if (PHM(2)) { pg8::SchedPlain S; S.o.init(NTOK / 256, NMAIN / 256, F.G, (int)blockIdx.x); S.A = (layer >= F8_WIN_FROM || I8_WIN_ALL) ? (const char*)xf8 : (const char*)hb; S.B = (const char*)(F.ws + WS_WIN) + (size_t)layer * NMAIN * DM * 2; S.tA = 256 * DM * 2; S.tB = 256 * DM * 2;
              LAS float* lb = (LAS float*)(F.lds + LDS_BIAS_OFF); const float* bg = F.inp(I_BGATE) + layer * 3 * DM;
              float bl[6];
#pragma unroll
              for (int k = 0; k < 6; ++k) bl[k] = bg[F.tid + k * 512];
              const pg8::RowScale RS = (moe || layer == 0) ? build_row_scale(F, S, false) : no_row_scale();
#pragma unroll
              for (int k = 0; k < 6; ++k) lb[F.tid + k * 512] = bl[k];
              __syncthreads();
              if (layer >= F8_WIN_FROM || I8_WIN_ALL) { S.tA = 256 * DM; S.tB = 256 * DM;
                  if (I8_WIN) { pg8::EpiWin E{a, bg, lb, 1.0f / (((layer & 1) ? i8_sxu(layer - 1) : I8_SXN) * I8_SW), F.ws + WS_G8, RS};
                      pg8::gemm_phase<pg8::EpiWin, pg8::SchedPlain, false, true>(F.lds, DM / 2, DM, DM, S, E); }
                  else { pg8::EpiWin E{a, bg, lb, 1.0f / (F8_SX * F8_SW), F.ws + WS_G8, RS};
                  pg8::gemm_phase<pg8::EpiWin, pg8::SchedPlain, true>(F.lds, DM / 2, DM, DM, S, E); }
              } else {
              pg8::EpiWin E{a, bg, lb, 1.0f, F.ws + WS_G8, RS};
              pg8::gemm_phase(F.lds, DM, DM * 2, DM * 2, S, E); } }
          }
        }
        SEAM(pb + 0);
        if (IN(pb + 1)) {
            const bool attn_first = (((int)blockIdx.x >> 3) & 1) != 0;
#pragma unroll 1
            for (int slot = 0; slot < 2; ++slot) {
              if ((slot == 0) == attn_first) { F.rethread(); if (PHM(6)) {
                LAS float* tab = (LAS float*)(F.lds + ATTN_TAB_OFF);
                { const float* rb = F.inp(I_RELB) + (size_t)layer * 8 * 192;
                  for (int i = F.tid; i < 8 * 192; i += 512) tab[i] = (rb[i] - rb[(i / 192) * 192 + 191]) * LOG2E; }
                asm volatile("s_waitcnt vmcnt(0)" ::: "memory");
                __syncthreads();
                const fa::AttnTensors AT{(const fa::bf16*)(a + A_Q), (const fa::bf16*)(a + A_K), (const fa::bf16*)(a + A_V), (fa::bf16*)(a + A_Q), (layer >= F8_BR_FROM) ? (unsigned char*)a + A8_ATT : nullptr};
                const int vcu = ((int)blockIdx.x % 8) * (F.G / 8) + (int)blockIdx.x / 8;
                fa::attn_phase<8>((char*)F.lds, AT, vcu, F.G, tab);
                __syncthreads(); } }
              else {
#pragma unroll 1
                for (int rep = (PROBE & 4) ? 0 : 1; rep < 2; ++rep) { F.rethread(); if (PHM(5)) sgu_phase(F, layer, rep == 0 ? A_CONV + 512 : A_SGU, (layer >= F8_BR_FROM) ? 1 : 0); }
#pragma unroll 1
                for (int rep = (PROBE & 2) ? 0 : 1; rep < 2; ++rep) { F.rethread(); if (PHM(4)) conv_phase(F, layer, (layer >= F8_BR_FROM) ? 1 : 0); } }
            } }
        SEAM(pb + 1);
        if (IN(pb + 2) && PHM(7)) {
            F.rethread();
            pg8::SchedBranch S; S.o.init(NTOK / 256, DM / 256, F.G, (int)blockIdx.x); S.abase = (const char*)a; S.W = (const char*)(F.ws + WS_WBR) + (size_t)layer * 3 * DM * 512 * 2; S.f8 = 0;
            if (layer >= F8_BR_FROM) { S.f8 = 1;
                pg8::EpiBranch E{a, F.ws + WS_G8, layer >= I8_WOUT_FROM ? 2 : 1, (layer >= I8_WOUT_FROM ? I8_SXM / F8_SX : 1.0f) / (F8_SW * 256.0f)};
                pg8::gemm_phase<pg8::EpiBranch, pg8::SchedBranch, true>(F.lds, 512 / 2, LDA * 2, 512, S, E);
            } else {
            pg8::EpiBranch E{a, F.ws + WS_G8, layer >= I8_WOUT_FROM ? 2 : (layer >= F8_WOUT_FROM ? 1 : 0), layer >= I8_WOUT_FROM ? I8_SXM : F8_SX};
            pg8::gemm_phase(F.lds, 512, LDA * 2, 512 * 2, S, E); }
        }
        SEAM(pb + 2);
        if (IN(pb + 3) && PHM(8)) {
            F.rethread();
            pg8::SchedPlain S; S.o.init(NTOK / 256, DM / 256, F.G, (int)blockIdx.x); S.A = (const char*)(a + A_G); S.B = (const char*)(F.ws + WS_WO) + (size_t)layer * DM * DM * 2; S.tA = 256 * (size_t)LDA * 2; S.tB = 256 * DM * 2;
            if (layer >= I8_WOUT_FROM) { S.tB = 256 * DM;
                pg8::EpiRes E{hb, xf8, F.inp(I_FFNG) + layer * DM, partb, 1.0f / (I8_SXM * I8_SW), (I8_UP && (layer != 0 || I8_UP_L0)) ? (moe ? 0 : 2) : ((layer == F8_DENSE_LAYER) ? 1 : 0), moe ? 0 : 1, i8_sxu(layer)};
                pg8::gemm_phase<pg8::EpiRes, pg8::SchedPlain, false, true>(F.lds, DM / 2, LDA * 2, DM, S, E);
            } else if (layer >= F8_WOUT_FROM) { S.tB = 256 * DM;
                pg8::EpiRes E{hb, xf8, F.inp(I_FFNG) + layer * DM, partb, 1.0f / (F8_SX * F8_SW), (I8_UP && (layer != 0 || I8_UP_L0)) ? (moe ? 0 : 2) : ((layer == F8_DENSE_LAYER) ? 1 : 0), moe ? 0 : 1, i8_sxu(layer)};
                pg8::gemm_phase<pg8::EpiRes, pg8::SchedPlain, true>(F.lds, DM / 2, LDA * 2, DM, S, E);
            } else {
            pg8::EpiRes E{hb, xf8, F.inp(I_FFNG) + layer * DM, partb, 1.0f, (I8_UP && (layer != 0 || I8_UP_L0)) ? (moe ? 0 : 2) : ((layer == F8_DENSE_LAYER) ? 1 : 0), moe ? 0 : 1, i8_sxu(layer)};
            pg8::gemm_phase(F.lds, DM, LDA * 2, DM * 2, S, E); }
        }
        SEAM(pb + 3);
        if (IN(pb + 4)) {
            F.rethread();
            if (moe) { if (PHM(9)) route_permute_phase(F, hb, F.inp(I_FFNG) + layer * DM, fi); }
        }
        if (moe) SEAM(pb + 4);
        if (IN(pb + 6)) {
#pragma unroll 1
          for (int rep = ((PROBE & 32) && !moe) || ((PROBE & 64) && moe) ? 0 : 1; rep < 2; ++rep) {
            F.rethread();
            if (!moe) { if (PHM(11)) {
                pg8::SchedPlain S; S.o.init(NTOK / 256, 2 * DFF / 256, F.G, (int)blockIdx.x); S.A = ((I8_UP && (layer != 0 || I8_UP_L0)) || layer == F8_DENSE_LAYER) ? (const char*)xf8 : (const char*)hb; S.B = (const char*)(F.ws + WS_FGU) + (size_t)fi * 2 * DFF * DM * 2; S.tA = 256 * DM * 2; S.tB = 256 * DM * 2;
                const pg8::RowScale RS = build_row_scale(F, S, false);
                if (I8_UP && (layer != 0 || I8_UP_L0)) { S.tA = 256 * DM; S.tB = 256 * DM;
                    if (layer == F8_DENSE_LAYER) { pg8::EpiSwigluF8 E{(unsigned char*)inter, DFF, 1.0f / (i8_sxu(layer) * I8_SW), F8_SI, RS};
                        pg8::gemm_phase<pg8::EpiSwigluF8, pg8::SchedPlain, false, true>(F.lds, DM / 2, DM, DM, S, E); }
                    else { pg8::EpiSwiglu E{inter, DFF, RS, 1.0f / (i8_sxu(layer) * I8_SW)};
                        pg8::gemm_phase<pg8::EpiSwiglu, pg8::SchedPlain, false, true>(F.lds, DM / 2, DM, DM, S, E); }
                } else if (layer == F8_DENSE_LAYER) { S.tA = 256 * DM; S.tB = 256 * DM;
                    pg8::EpiSwigluF8 E{(unsigned char*)inter, DFF, 1.0f / (F8_SX * F8_SW), F8_SI, RS};
                    pg8::gemm_phase<pg8::EpiSwigluF8, pg8::SchedPlain, true>(F.lds, DM / 2, DM, DM, S, E);
                } else {
                pg8::EpiSwiglu E{inter, DFF, RS, 1.0f};
                pg8::gemm_phase(F.lds, DM, DM * 2, DM * 2, S, E); } }
            } else if (PHM(12)) {
                int tp[9]; moe_tile_prefix(F, fi, tp);
                pg8::SchedMoe S; S.o.init(tp[8], 2 * DFE / 256, F.G, (int)blockIdx.x); S.A = (const char*)ybuf; S.B = (const char*)(F.ws + WS_MGU) + (size_t)fi * NEXP * 2 * DFE * DM; S.tA = 256 * DM; S.tB = 256 * DM; S.bexp = (size_t)2 * DFE * DM;
                S.tp1 = tp[1]; S.tp2 = tp[2]; S.tp3 = tp[3]; S.tp4 = tp[4]; S.tp5 = tp[5]; S.tp6 = tp[6]; S.tp7 = tp[7];
                if (I8_UP) { pg8::EpiSwigluF8 E{(unsigned char*)inter, DFE, 1.0f / (I8_SXN * I8_SW), F8_SI, no_row_scale()};
                    pg8::gemm_phase<pg8::EpiSwigluF8, pg8::SchedMoe, false, true>(F.lds, DM / 2, DM, DM, S, E); }
                else { pg8::EpiSwigluF8 E{(unsigned char*)inter, DFE, 1.0f / (F8_SX * F8_SW), F8_SI, no_row_scale()};
                pg8::gemm_phase<pg8::EpiSwigluF8, pg8::SchedMoe, true>(F.lds, DM / 2, DM, DM, S, E); }
            }
          }
        }
        SEAM(pb + 6);
        if (IN(pb + 7)) {
#pragma unroll 1
          for (int rep = ((PROBE & 128) && moe) ? 0 : 1; rep < 2; ++rep) {
            F.rethread();
            if (!moe) { if (PHM(13)) {
                pg8::SchedPlain S; S.o.init(NTOK / 256, DM / 256, F.G, (int)blockIdx.x); S.A = (const char*)inter; S.B = (const char*)(F.ws + WS_FD) + (size_t)fi * DM * DFF * 2; S.tA = 256 * (size_t)DFF * 2; S.tB = 256 * (size_t)DFF * 2;
                if (layer == F8_DENSE_LAYER) { S.tA = 256 * (size_t)DFF; S.tB = 256 * (size_t)DFF;
                    pg8::EpiRes E{hb, xf8, F.inp(I_MIXG) + (layer + 1) * DM, partb, 1.0f / (F8_SI * F8_SW), (layer + 1 >= F8_GATE_FROM) ? (I8_WIN ? 2 : 1) : 0, 1, i8_sxu(layer)};
                    pg8::gemm_phase<pg8::EpiRes, pg8::SchedPlain, true>(F.lds, DFF / 2, DFF, DFF, S, E);
                } else {
                pg8::EpiRes E{hb, xf8, F.inp(I_MIXG) + (layer + 1) * DM, partb, 1.0f, (layer + 1 >= F8_GATE_FROM) ? (I8_WIN ? 2 : 1) : 0, 1, i8_sxu(layer)};
                pg8::gemm_phase(F.lds, DFF, DFF * 2, DFF * 2, S, E); } }
            } else if (PHM(14)) {
                int tp[9]; moe_tile_prefix(F, fi, tp);
                const bool split = SPLIT_FINAL && layer == DEPTH - 1 && F.G == 256 && !(PROBE & 128);
                pg8::SchedMoe S; S.o.init(split ? 256 : tp[8], DM / 256, F.G, (int)blockIdx.x); S.A = (const char*)inter; S.B = (const char*)(F.ws + WS_MD) + (size_t)fi * NEXP * DM * DFE; S.tA = 256 * (size_t)DFE; S.tB = 256 * (size_t)DFE; S.bexp = (size_t)DM * DFE;
                S.tp1 = tp[1]; S.tp2 = tp[2]; S.tp3 = tp[3]; S.tp4 = tp[4]; S.tp5 = tp[5]; S.tp6 = tp[6]; S.tp7 = tp[7];
                pg8::EpiBf16Plain E{ybuf, DM, 1.0f / (F8_SI * F8_SW), no_row_scale()};
                pg8::gemm_phase<pg8::EpiBf16Plain, pg8::SchedMoe, true>(F.lds, DFE / 2, DFE, DFE, S, E);
                if (split) {
                    unsigned* cnt = F.ctl + CW_P7A;
                    asm volatile("s_waitcnt vmcnt(0)" ::: "memory"); __syncthreads();
                    if (F.tid == 0) { __builtin_amdgcn_fence(__ATOMIC_RELEASE, "agent"); asm volatile("s_waitcnt vmcnt(0)" ::: "memory"); (void)__hip_atomic_fetch_add(cnt, 1u, __ATOMIC_RELAXED, __HIP_MEMORY_SCOPE_AGENT); }
                    const int ntail = (tp[8] - 256) * 4 > 0 ? (tp[8] - 256) * 4 : 0;
                    if ((int)blockIdx.x < ntail) {
                        pg8::SchedTail T; T.m = S; T.pm = 256 + ((int)blockIdx.x >> 2); T.pn = (int)blockIdx.x & 3;
                        pg8::gemm_phase<pg8::EpiBf16Plain, pg8::SchedTail, true>(F.lds, DFE / 2, DFE, DFE, T, E);
                    } else {
                        if (F.wave == 0) { unsigned sp = 0;
                            while ((unsigned)__builtin_amdgcn_readfirstlane((int)__hip_atomic_load(cnt, __ATOMIC_RELAXED, __HIP_MEMORY_SCOPE_AGENT)) < (unsigned)F.G) { __builtin_amdgcn_s_sleep(2); if (++sp > (1u << 22)) break; }
                            __builtin_amdgcn_fence(__ATOMIC_ACQUIRE, "agent"); asm volatile("s_waitcnt vmcnt(0)" ::: "memory"); }
                        __syncthreads();
                        F.rethread();
                        const int nfree = F.G - ntail, j = (int)blockIdx.x - ntail;
                        int Rw = (NTOK + nfree - 1) / nfree; Rw = (Rw + 7) & ~7; const int rpwv = Rw >> 3;
                        const long r0 = (long)j * Rw + (long)F.wave * rpwv; long nr = (long)NTOK - r0; if (nr > rpwv) nr = rpwv;
                        combine_final_rows<1>(F, hb, F.inp(I_FING), F.out, (size_t)r0, (int)nr);
                    }
                }
                if (layer == 1 && (int)blockIdx.x >= TAIL_WG0 && F.G > TAIL_WG0) {
                    F.rethread(); Frame F2 = F; F2.cvG = F.G - TAIL_WG0; F2.cvId = (int)blockIdx.x - TAIL_WG0; int tb2 = 0;
                    cvt_moe_layer(F2, 1, tb2, 0, MOE1_TAIL_EXPERTS); }
            }
          }
        }
        SEAM(pb + 7);
        if (IN(pb + 8)) {
            F.rethread();
            const float* gnext = (layer == DEPTH - 1) ? F.inp(I_FING) : F.inp(I_MIXG) + (layer + 1) * DM;
            if (moe) { if (PHM(15)) {
                if (layer == DEPTH - 1) { if (SPLIT_FINAL && F.G == 256 && !(PROBE & 128)) combine_final_rows<2>(F, hb, gnext, F.out, (size_t)blockIdx.x * (NTOK / 256) + (size_t)F.wave * 16, 16);
                                          else combine_norm_phase<true>(F, hb, gnext, nullptr, F.out); }
                else combine_norm_phase<false>(F, hb, gnext, xf8, nullptr); } }
        }
        if (moe && layer != DEPTH - 1) SEAM(pb + 8);
    }
#undef IN
#undef SEAM
#undef GRID_BAR
#undef a
#undef hb
#undef xf8
#undef partb
#undef inter
#undef ybuf
}

extern "C" void kernel_launch(void* const* d_in, const int* in_sizes, int n_in, void* d_out, int out_size, void* d_ws, size_t ws_size, hipStream_t stream) {
    static int grid = 0;
    if (grid == 0) {
        if (n_in != 26 || in_sizes[0] != NTOK * DM || out_size != NTOK * DM || ws_size < WS_END) { fprintf(stderr, "kernel_launch: unexpected shapes / workspace (n_in %d, ws %zu, need %zu)\n", n_in, ws_size, (size_t)WS_END); grid = -1; return; }
        int dev = 0, cus = 0, per_cu = 0;
        if (hipGetDevice(&dev) != hipSuccess || hipDeviceGetAttribute(&cus, hipDeviceAttributeMultiprocessorCount, dev) != hipSuccess) { grid = -1; return; }
        if (hipFuncSetAttribute((const void*)trunk_fwd, hipFuncAttributeMaxDynamicSharedMemorySize, LDS_BYTES) != hipSuccess) { fprintf(stderr, "kernel_launch: hipFuncSetAttribute failed\n"); grid = -1; return; }
        if (hipOccupancyMaxActiveBlocksPerMultiprocessor(&per_cu, (const void*)trunk_fwd, 512, LDS_BYTES) != hipSuccess || per_cu < 1) { fprintf(stderr, "kernel_launch: occupancy query reports %d\n", per_cu); }
        (void)hipGetLastError();
        grid = cus;
        if (grid > 256) grid = 256;
    }
    if (grid < 0) return;
    if (hipMemsetAsync((char*)d_ws + WS_CTL, 0, CTL_ZERO_BYTES, stream) != hipSuccess) return;
    Args a{};
    for (int i = 0; i < 26; ++i) a.in[i] = (const float*)d_in[i];
    a.out = (float*)d_out; a.ws = (unsigned char*)d_ws;
#if MK_MULTI
    for (int p = 0; p < N_PHASES; ++p) { a.ph_lo = p; a.ph_hi = p + 1; hipLaunchKernelGGL(trunk_fwd, dim3(grid), dim3(512), LDS_BYTES, stream, a); }
#else
    a.ph_lo = 0; a.ph_hi = N_PHASES;
    hipLaunchKernelGGL(trunk_fwd, dim3(grid), dim3(512), LDS_BYTES, stream, a);
#endif
}
```

```cpp
#include <hip/hip_runtime.h>
#include <hip/hip_bf16.h>
#include <cmath>
#include <cstdio>
#include <cstdint>

#ifndef MK_MULTI
#define MK_MULTI 0
#endif

#ifndef PROBE
#define PROBE 0
#endif
#ifndef PHMASK
#define PHMASK 0xFFFFFFFFu
#endif
#define PHM(b) ((PHMASK >> (b)) & 1u)
#define LAS __attribute__((address_space(3)))
#define GAS __attribute__((address_space(1)))
typedef unsigned short bf16;
typedef short bf16x8 __attribute__((ext_vector_type(8)));
typedef short s16x4 __attribute__((ext_vector_type(4)));
typedef float f32x4 __attribute__((ext_vector_type(4)));
typedef float f32x2 __attribute__((ext_vector_type(2)));
typedef unsigned u32x4 __attribute__((ext_vector_type(4)));
typedef unsigned u32x2 __attribute__((ext_vector_type(2)));
typedef int i32x4 __attribute__((ext_vector_type(4)));
typedef int i32x8 __attribute__((ext_vector_type(8)));

constexpr int DM = 1024, NBATCH = 4, SEQ = 8192, NTOK = NBATCH * SEQ, DEPTH = 4;
constexpr int NIN = 6656;
constexpr int LDA = 5120;
constexpr int A_CONV = 0, A_SGU = 1024, A_Q = 2048, A_K = 2560, A_HC = 3072, A_G = 3584, A_V = 4608;
constexpr int A8_HC = A_HC * 2, A8_SGU = (A_SGU + 512) * 2, A8_ATT = 1024;
constexpr int G_COL0 = 3072, NGATE = 3072;
constexpr int NMAIN = 6656;
constexpr int DFF = 2816, NEXP = 8, DFE = 3584;
constexpr int MAXSLOT = 67584;
constexpr float EPS = 1e-6f;
constexpr float LOG2E = 1.4426950408889634f;
constexpr int F8_WIN_FROM = 2;
constexpr int MOE1_TAIL_EXPERTS = 3, TAIL_WG0 = 32;
constexpr bool SPLIT_FINAL = true;
constexpr int F8_BR_FROM = 2;
constexpr int I8_WOUT_FROM = 2;
constexpr float I8_SXM = 32.0f;
constexpr int F8_WOUT_FROM = 2;
static_assert(F8_BR_FROM >= F8_WOUT_FROM, "an fp8 branch GEMM writes merged through the e4m3 path of the branch epilogue");
constexpr int F8_GATE_FROM = 0;
static_assert(F8_GATE_FROM >= 0 && F8_GATE_FROM <= 2, "the e4m3 gate weights of layers 0 / 1 live in the free halves of layer 2's / 3's w_in slots");
static_assert(F8_WIN_FROM == 2, "the combine phase of layer 1 writes the e4m3 operand of layer 2's w_in");
constexpr int F8_DENSE_LAYER = 2;
constexpr bool I8_WIN_ALL = true, I8_UP = true, I8_UP_L0 = true;
constexpr bool I8_WIN = true;
constexpr float I8_SXU0 = 16.0f, I8_SXU2 = 13.0f;
__host__ __device__ constexpr float i8_sxu(int producer_layer) { return producer_layer == 0 ? I8_SXU0 : I8_SXU2; }
constexpr float I8_SXN = 24.0f, I8_SXU = 10.0f, I8_SW = 800.0f;
constexpr float F8_SX = 8.0f, F8_SW = 64.0f, F8_SI = 8.0f;

constexpr size_t MiB = 1u << 20;
constexpr size_t WS_CTL = 0, CTL_ZERO_BYTES = 65536;
constexpr size_t WS_ROUTE = 1 * MiB;
constexpr size_t WS_WIN = 2 * MiB;
constexpr size_t WS_WG8 = WS_WIN + (size_t)2 * 6656 * 1024 * 2 + (size_t)6656 * 1024;
constexpr size_t WS_WG8_STEP = (size_t)6656 * 1024 * 2;
constexpr size_t WS_WBR = 54 * MiB;
constexpr size_t WS_WO = 66 * MiB;
constexpr size_t WS_SGUW = 74 * MiB;
constexpr size_t WS_FGU = 75 * MiB;
constexpr size_t WS_FD = 97 * MiB;
constexpr size_t WS_MGU = 108 * MiB;
constexpr size_t WS_MD = 220 * MiB;
constexpr size_t WS_XN = 276 * MiB;
constexpr size_t WS_BIG = 340 * MiB;
constexpr size_t WS_G8 = WS_BIG + 320 * MiB;
constexpr size_t WS_XF8 = WS_BIG + 416 * MiB;
constexpr size_t WS_Y = 802 * MiB;
constexpr size_t WS_PART = 934 * MiB;
constexpr size_t WS_END = 936 * MiB;
constexpr int CW_BAR = 4096;
constexpr int CW_CNT = 8192;
constexpr int CW_ARR = 9216;
constexpr int CW_P7A = 9344;
constexpr int CW_TAB = 10240;

constexpr int ATTN_TAB_OFF = 133120;
constexpr int LDS_BIAS_OFF = 131072;
constexpr int LDS_SCRATCH = 143360;
constexpr int LDSCTL_OFF = LDS_SCRATCH;
constexpr int LDS_ROWSCALE_OFF = 147456;
constexpr int LDS_BYTES = 155648;

__device__ __forceinline__ unsigned cvt_pk_bf16(float lo, float hi) { unsigned r; asm volatile("v_cvt_pk_bf16_f32 %0, %1, %2" : "=v"(r) : "v"(lo), "v"(hi)); return r; }
__device__ __forceinline__ float clamp448(float v) { return __builtin_amdgcn_fmed3f(v, -448.0f, 448.0f); }
__device__ __forceinline__ unsigned cvt4_fp8(float a, float b, float c, float d) { int p = __builtin_amdgcn_cvt_pk_fp8_f32(clamp448(a), clamp448(b), 0, false); p = __builtin_amdgcn_cvt_pk_fp8_f32(clamp448(c), clamp448(d), p, true); return (unsigned)p; }
__device__ __forceinline__ unsigned cvt4_i8(float a, float b, float c, float d) {
    const float M = 12582912.0f;
    const unsigned ua = __float_as_uint(__builtin_amdgcn_fmed3f(a, -127.0f, 127.0f) + M), ub = __float_as_uint(__builtin_amdgcn_fmed3f(b, -127.0f, 127.0f) + M);
    const unsigned uc = __float_as_uint(__builtin_amdgcn_fmed3f(c, -127.0f, 127.0f) + M), ud = __float_as_uint(__builtin_amdgcn_fmed3f(d, -127.0f, 127.0f) + M);
    return __builtin_amdgcn_perm(ub, ua, 0x0c0c0400u) | __builtin_amdgcn_perm(ud, uc, 0x04000c0cu);
}
__device__ __forceinline__ float bflo(unsigned p) { return __uint_as_float(p << 16); }
__device__ __forceinline__ float bfhi(unsigned p) { return __uint_as_float(p & 0xffff0000u); }
__device__ __forceinline__ float fast_sigmoid(float x) { return __builtin_amdgcn_rcpf(1.0f + __builtin_amdgcn_exp2f(-x * LOG2E)); }
template <int CTRL, int ROWMASK> __device__ __forceinline__ float dpp_f(float v) { return __builtin_bit_cast(float, __builtin_amdgcn_update_dpp(0, __builtin_bit_cast(int, v), CTRL, ROWMASK, 0xF, false)); }
__device__ __forceinline__ float wave_sum(float v) {
    v += dpp_f<0xB1, 0xF>(v); v += dpp_f<0x4E, 0xF>(v); v += dpp_f<0x141, 0xF>(v); v += dpp_f<0x140, 0xF>(v);
    v += dpp_f<0x142, 0xA>(v); v += dpp_f<0x143, 0xC>(v);
    return __builtin_bit_cast(float, __builtin_amdgcn_readlane(__builtin_bit_cast(int, v), 63));
}
__device__ __forceinline__ f32x2 gelu_pk(f32x2 v) {
    const f32x2 av = __builtin_elementwise_abs(v), d = av * 0.2316418882f + 1.0f;
    f32x2 t; t.x = __builtin_amdgcn_rcpf(d.x); t.y = __builtin_amdgcn_rcpf(d.y);
    f32x2 q = t * 0.5307027145f + (-0.7265760135f); q = q * t + 0.7107068705f; q = q * t + (-0.142248368f); q = q * t + 0.127414796f; q = q * t;
    const f32x2 s = (v * v) * (-0.72134752044f);
    f32x2 e; e.x = __builtin_amdgcn_exp2f(s.x); e.y = __builtin_amdgcn_exp2f(s.y);
    const f32x2 m = v * (q * e), r = v - m;
    f32x2 o; o.x = v.x < 0.f ? m.x : r.x; o.y = v.y < 0.f ? m.y : r.y; return o;
}

#define XB_TMO      128
#define XB_XCNT(j)  (256  + 64 * (j))
#define XB_XSUB(j)  (1280 + 64 * (j))
#define XB_XGEN(j)  (2304 + 64 * (j))
#define XB_TOP      3328
#define XB_TOPGEN   3392
#define XCD_BAR_WORDS 3456
#define XB_SPIN_CAP (1u << 18)
__device__ __forceinline__ unsigned xb_ld(unsigned* p)              { return __hip_atomic_load(p, __ATOMIC_RELAXED, __HIP_MEMORY_SCOPE_AGENT); }
__device__ __forceinline__ unsigned xb_add(unsigned* p, unsigned v) { return __hip_atomic_fetch_add(p, v, __ATOMIC_RELAXED, __HIP_MEMORY_SCOPE_AGENT); }
__device__ __forceinline__ unsigned xb_xcc_id() { return (unsigned)__builtin_amdgcn_s_getreg((3 << 11) | 20) & 0xFu; }
#define XB_SPIN(cond, bar) do { unsigned _sp = 0; while (cond) { __builtin_amdgcn_s_sleep(1); \
    if ((++_sp & 255u) == 0u) { if (xb_ld(&(bar)[XB_TMO])) break; if (_sp > XB_SPIN_CAP) { atomicAdd(&(bar)[XB_TMO], 1u); break; } } } } while (0)
struct XcdBarrier { unsigned* bar; unsigned x; volatile LAS unsigned* st; };
__device__ __forceinline__ XcdBarrier xcd_barrier_post(unsigned* bar, volatile LAS unsigned* st) {
    XcdBarrier b; b.bar = bar; b.x = xb_xcc_id(); b.st = st;
    if (threadIdx.x == 0) (void)xb_add(&bar[XB_XCNT(b.x)], 1u);
    return b;
}
__device__ __forceinline__ void xcd_barrier_complete(unsigned* bar, unsigned x, unsigned& nloc, unsigned& nx) {
    const unsigned G = gridDim.x * gridDim.y * gridDim.z;
    unsigned sum, cnt, mine, sp = 0u;
    for (;;) {
        sum = 0u; cnt = 0u; mine = 0u;
#pragma unroll
        for (unsigned j = 0; j < 16; ++j) { const unsigned c = xb_ld(&bar[XB_XCNT(j)]); sum += c; cnt += (c > 0u) ? 1u : 0u; mine = (j == x) ? c : mine; }
        if (sum == G) break;
        __builtin_amdgcn_s_sleep(1);
        if ((++sp & 255u) == 0u) { if (xb_ld(&bar[XB_TMO])) break; if (sp > XB_SPIN_CAP) { atomicAdd(&bar[XB_TMO], 1u); break; } }
    }
    nloc = mine > 0u ? mine : 1u; nx = cnt > 0u ? cnt : 1u;
}
__device__ __forceinline__ void xcd_barrier(const XcdBarrier& b) {
    asm volatile("s_waitcnt vmcnt(0)" ::: "memory");
    __syncthreads();
    if (threadIdx.x == 0) {
        unsigned* bar = b.bar;
        __builtin_amdgcn_s_waitcnt(0);
        unsigned nloc = b.st[0], nx = b.st[1];
        if (nloc == 0u) { xcd_barrier_complete(bar, b.x, nloc, nx); b.st[0] = nloc; b.st[1] = nx; }
        const unsigned old = xb_add(&bar[XB_XSUB(b.x)], 1u);
        const unsigned gen = old / nloc;
        if (old + 1u == (gen + 1u) * nloc) {
            __builtin_amdgcn_fence(__ATOMIC_RELEASE, "agent");
            asm volatile("s_waitcnt vmcnt(0)" ::: "memory");
            const unsigned og = xb_add(&bar[XB_TOP], 1u);
            const unsigned tg = og / nx;
            if (og + 1u == (tg + 1u) * nx) xb_add(&bar[XB_TOPGEN], 1u);
            else XB_SPIN(xb_ld(&bar[XB_TOPGEN]) == tg, bar);
            __builtin_amdgcn_fence(__ATOMIC_ACQUIRE, "agent");
            xb_add(&bar[XB_XGEN(b.x)], 1u);
            asm volatile("s_waitcnt vmcnt(0)" ::: "memory");
        } else {
            XB_SPIN(xb_ld(&bar[XB_XGEN(b.x)]) == gen, bar);
            __builtin_amdgcn_fence(__ATOMIC_ACQUIRE, "agent");
            asm volatile("s_waitcnt vmcnt(0)" ::: "memory");
        }
    }
    __syncthreads();
}

namespace pg8 {
constexpr int BM = 256, BK = 64, HALF = 128, HTB = HALF * BK * 2, STAGE_BYTES = 8 * HTB, NXCD = 8, WGM = 8;
__device__ __forceinline__ int lds_byte(int r, int c) { const int st = (r >> 4) * 2 + (c >> 5), rr = r & 15, cc = c & 31, ob = rr * 64 + cc * 2; return st * 1024 + (ob ^ (((ob >> 9) & 1) << 5)); }
__device__ __forceinline__ void stage_rc(int b, int& R, int& C) { const int st = b / 1024, sb = b % 1024, swz = sb ^ (((sb >> 9) & 1) << 5); R = (st >> 1) * 16 + swz / 64; C = (st & 1) * 32 + (swz % 64) / 2; }
__device__ __forceinline__ int perm32(int rho) { const int n = rho >> 4, i = rho & 15; return 8 * (i >> 2) + 4 * n + (i & 3); }

struct Unit { int pm, pn, kind; const char* A; const char* B; };

struct TileOrder {
    int nM, nN, nwg, G, c;
    __device__ __forceinline__ void init(int nM_, int nN_, int G_, int c_) { nM = nM_; nN = nN_; nwg = nM * nN; G = G_; c = c_; }
    __device__ __forceinline__ bool tile(int i, int& pm, int& pn) const {
        const long L = (long)i * G + c; if (L >= nwg) return false;
        int wgid = (int)L; { const int q = nwg / NXCD, r = nwg % NXCD, xcd = wgid % NXCD, off = wgid / NXCD; wgid = (xcd < r ? xcd * (q + 1) : r * (q + 1) + (xcd - r) * q) + off; }
        const int nig = WGM * nN, gid = wgid / nig, fm = gid * WGM, gsz = (nM - fm) < WGM ? (nM - fm) : WGM;
        pm = fm + ((wgid % nig) % gsz); pn = (wgid % nig) / gsz; return true;
    }
};

__device__ __forceinline__ const char* uniform_ptr(const char* p) { const unsigned long long v = (unsigned long long)p;
    const unsigned lo = __builtin_amdgcn_readfirstlane((unsigned)v), hi = __builtin_amdgcn_readfirstlane((unsigned)(v >> 32)); return (const char*)(((unsigned long long)hi << 32) | lo); }
__device__ __forceinline__ void glds16(const char* sbase, unsigned voff, unsigned ldsaddr) {
    unsigned keep;
    asm volatile("s_mov_b32 %0, m0\n\ts_mov_b32 m0, %3\n\ts_nop 0\n\tglobal_load_lds_dwordx4 %1, %2\n\ts_mov_b32 m0, %0"
                 : "=&s"(keep) : "v"(voff), "s"(sbase), "s"(ldsaddr) : "memory");
}
__device__ __forceinline__ void mfma_f8_inplace(f32x4& c, const i32x8 a, const i32x8 b, const unsigned sc) {
    asm volatile("v_mfma_scale_f32_16x16x128_f8f6f4 %0, %1, %2, %0, %3, %3 op_sel_hi:[0,0,0]" : "+v"(c) : "v"(a), "v"(b), "v"(sc));
}
template <class Epi, class Sched, bool FP8 = false, bool I8 = false>
__device__ __forceinline__ void gemm_phase(LAS unsigned char* lds, const int K, const unsigned lda2, const unsigned ldb2, const Sched& S, const Epi& E) {
    int tid_ = threadIdx.x; asm volatile("" : "+v"(tid_));
    const int tid = tid_, wid = __builtin_amdgcn_readfirstlane(tid >> 6), lane = tid & 63, wr = wid >> 2, wc = wid & 3, fr = lane & 15, fq = lane >> 4;
    int nt_ = K / BK; asm volatile("" : "+s"(nt_)); const int nt = nt_;
    unsigned voffA[2], voffB[2];
#pragma unroll
    for (int i = 0; i < 2; ++i) { int R, C; stage_rc(tid * 16 + i * 8192, R, C); const int Rb = Epi::PERM ? ((R & ~31) + perm32(R & 31)) : R;
        voffA[i] = (unsigned)R * lda2 + (unsigned)C * 2u; voffB[i] = (unsigned)Rb * ldb2 + (unsigned)C * 2u; }
    const size_t kstep = (size_t)(BK * 2);
    const size_t hstepA = (size_t)HALF * lda2, hstepB = (size_t)HALF * ldb2;
    const unsigned ldsw = (unsigned)wid * 1024u;
    const unsigned lds0 = (unsigned)(size_t)lds;
    const int aoff = lds_byte(wr * 64 + fr, fq * 8), boff = lds_byte(wc * 32 + fr, fq * 8);
#define PG8_SA(b, h) (((b) * 2 + (h)) * HTB)
#define PG8_SB(b, h) ((4 + (b) * 2 + (h)) * HTB)
#define PG8_STAGE(bufoff, gbase, voff) do { const char* _gb = (const char*)(gbase); const unsigned _la = lds0 + (unsigned)(bufoff) + ldsw; \
        glds16(_gb, (voff)[0], _la); glds16(_gb, (voff)[1], _la + 8192u); } while (0)
#define PG8_LDA(dst, b, h) do { _Pragma("unroll") for (int m = 0; m < 4; ++m) _Pragma("unroll") for (int k = 0; k < 2; ++k) dst[m][k] = *(const LAS bf16x8*)(lds + PG8_SA(b, h) + aoff + m * 2048 + k * 1024); } while (0)
#define PG8_LDB(dst, b, h) do { _Pragma("unroll") for (int n = 0; n < 2; ++n) _Pragma("unroll") for (int k = 0; k < 2; ++k) dst[n][k] = *(const LAS bf16x8*)(lds + PG8_SB(b, h) + boff + n * 2048 + k * 1024); } while (0)
#define PG8_CAT(x) __builtin_shufflevector(__builtin_bit_cast(i32x4, (x)[0]), __builtin_bit_cast(i32x4, (x)[1]), 0, 1, 2, 3, 4, 5, 6, 7)
#define PG8_MMA(ai, bj, At, Bt) do { __builtin_amdgcn_s_setprio(1); \
        if constexpr (FP8) { _Pragma("unroll") for (int m = 0; m < 4; ++m) _Pragma("unroll") for (int n = 0; n < 2; ++n) \
            mfma_f8_inplace(acc[ai][bj][m][n], PG8_CAT(Bt[n]), PG8_CAT(At[m]), f8scale); } \
        else if constexpr (I8) { _Pragma("unroll") for (int m = 0; m < 4; ++m) _Pragma("unroll") for (int n = 0; n < 2; ++n) _Pragma("unroll") for (int k = 0; k < 2; ++k) \
            acc[ai][bj][m][n] = __builtin_bit_cast(f32x4, __builtin_amdgcn_mfma_i32_16x16x64_i8(__builtin_bit_cast(i32x4, Bt[n][k]), __builtin_bit_cast(i32x4, At[m][k]), __builtin_bit_cast(i32x4, acc[ai][bj][m][n]), 0, 0, 0)); } \
        else { _Pragma("unroll") for (int m = 0; m < 4; ++m) _Pragma("unroll") for (int n = 0; n < 2; ++n) _Pragma("unroll") for (int k = 0; k < 2; ++k) \
            acc[ai][bj][m][n] = __builtin_amdgcn_mfma_f32_16x16x32_bf16(Bt[n][k], At[m][k], acc[ai][bj][m][n], 0, 0, 0); } \
        __builtin_amdgcn_s_setprio(0); } while (0)
#define PG8_WAIT_V(n) asm volatile("s_waitcnt vmcnt(" #n ")" ::: "memory")
#define PG8_WAIT_L(n) asm volatile("s_waitcnt lgkmcnt(" #n ")" ::: "memory")
#define PG8_BAR __builtin_amdgcn_s_barrier()
#define PG8_SCHED __builtin_amdgcn_sched_barrier(0)
    unsigned f8scale = 0x7f7f7f7fu; asm volatile("" : "+v"(f8scale));
    Unit cur, nxt; int ui = 0;
    if (!S.next(0, cur)) return;
    cur.A = uniform_ptr(cur.A); cur.B = uniform_ptr(cur.B);
    f32x4 acc[2][2][4][2];
#pragma unroll
    for (int a = 0; a < 2; ++a)
#pragma unroll
        for (int b = 0; b < 2; ++b)
#pragma unroll
            for (int m = 0; m < 4; ++m)
#pragma unroll
                for (int n = 0; n < 2; ++n) acc[a][b][m][n] = (f32x4){0.f, 0.f, 0.f, 0.f};
    bf16x8 At[4][2], B0[2][2], B1[2][2];
    const char* cA = cur.A; const char* cB = cur.B;
    PG8_STAGE(PG8_SB(0, 0), cB, voffB); PG8_STAGE(PG8_SB(0, 1), cB + hstepB, voffB); PG8_STAGE(PG8_SA(0, 0), cA, voffA); PG8_STAGE(PG8_SA(0, 1), cA + hstepA, voffA);
    if (wr == 1) PG8_BAR;
    PG8_WAIT_V(2); PG8_BAR;
    PG8_STAGE(PG8_SB(1, 0), cB + kstep, voffB); PG8_STAGE(PG8_SA(1, 0), cA + kstep, voffA); PG8_STAGE(PG8_SB(1, 1), cB + hstepB + kstep, voffB);
    PG8_WAIT_V(6); PG8_BAR;
    for (;;) {
        const bool has_next = S.next(ui + 1, nxt);
        const char* nA = uniform_ptr(has_next ? nxt.A : cA); const char* nB = uniform_ptr(has_next ? nxt.B : cB);
#pragma unroll 1
        for (int t = 0; t < nt; t += 2) {
            const bool last = (t == nt - 2);
            const char* a1 = cA + (size_t)(t + 1) * kstep;
            const char* a2 = last ? nA : cA + (size_t)(t + 2) * kstep; const char* b2 = last ? nB : cB + (size_t)(t + 2) * kstep;
            const char* a3 = a2 + kstep; const char* b3 = b2 + kstep;
            PG8_LDB(B0, 0, 0); PG8_LDB(B1, 0, 1); PG8_SCHED; PG8_LDA(At, 0, 0); PG8_STAGE(PG8_SA(1, 1), a1 + hstepA, voffA);
            PG8_WAIT_V(8); PG8_WAIT_L(0); PG8_BAR; PG8_MMA(0, 0, At, B0); PG8_MMA(0, 1, At, B1); PG8_BAR; PG8_SCHED;
            PG8_LDA(At, 0, 1); PG8_STAGE(PG8_SB(0, 0), b2, voffB); PG8_STAGE(PG8_SB(0, 1), b2 + hstepB, voffB); PG8_STAGE(PG8_SA(0, 0), a2, voffA);
            PG8_WAIT_V(8); PG8_WAIT_L(0); PG8_BAR; PG8_MMA(1, 0, At, B0); PG8_MMA(1, 1, At, B1); PG8_BAR; PG8_SCHED;
            PG8_LDB(B0, 1, 0); PG8_LDB(B1, 1, 1); PG8_SCHED; PG8_LDA(At, 1, 0); PG8_STAGE(PG8_SA(0, 1), a2 + hstepA, voffA);
            PG8_WAIT_V(8); PG8_WAIT_L(0); PG8_BAR; PG8_MMA(0, 0, At, B0); PG8_MMA(0, 1, At, B1); PG8_BAR; PG8_SCHED;
            PG8_LDA(At, 1, 1); PG8_STAGE(PG8_SB(1, 0), b3, voffB); PG8_STAGE(PG8_SB(1, 1), b3 + hstepB, voffB); PG8_STAGE(PG8_SA(1, 0), a3, voffA);
            PG8_WAIT_V(8); PG8_WAIT_L(0); PG8_BAR; PG8_MMA(1, 0, At, B0); PG8_MMA(1, 1, At, B1); PG8_BAR; PG8_SCHED;
        }
        if (wr == 0) PG8_BAR;
        if constexpr (FP8) asm volatile("s_nop 15\n\ts_nop 15\n\ts_nop 15" ::: "memory");
        if constexpr (I8) {
#pragma unroll
            for (int a = 0; a < 2; ++a)
#pragma unroll
                for (int b = 0; b < 2; ++b)
#pragma unroll
                    for (int m = 0; m < 4; ++m)
#pragma unroll
                        for (int n = 0; n < 2; ++n) acc[a][b][m][n] = __builtin_convertvector(__builtin_bit_cast(i32x4, acc[a][b][m][n]), f32x4); }
        if constexpr (Epi::INPLACE) { E.inplace(acc, cur, wr, wc, fr, fq); if (!has_next) break; }
        else {
        E(acc, cur, wr, wc, fr, fq);
        if (!has_next) break;
#pragma unroll
        for (int a = 0; a < 2; ++a)
#pragma unroll
            for (int b = 0; b < 2; ++b)
#pragma unroll
                for (int m = 0; m < 4; ++m)
#pragma unroll
                    for (int n = 0; n < 2; ++n) { f32x2 z0, z1; asm volatile("v_mov_b64 %0, 0\n\tv_mov_b64 %1, 0" : "=v"(z0), "=v"(z1)); acc[a][b][m][n] = (f32x4){z0.x, z0.y, z1.x, z1.y}; }
        }
        cur = nxt; cA = nA; cB = nB; ++ui;
        if (wr == 1) PG8_BAR;
    }
    PG8_WAIT_V(0);
    PG8_BAR;
#undef PG8_SA
#undef PG8_SB
#undef PG8_STAGE
#undef PG8_LDA
#undef PG8_LDB
#undef PG8_MMA
#undef PG8_CAT
#undef PG8_WAIT_V
#undef PG8_WAIT_L
#undef PG8_BAR
#undef PG8_SCHED
}

struct SchedPlain {
    TileOrder o; const char* A; const char* B; size_t tA, tB;
    __device__ __forceinline__ bool next(int i, Unit& u) const { if (!o.tile(i, u.pm, u.pn)) return false; u.kind = 0; u.A = A + (size_t)u.pm * tA; u.B = B + (size_t)u.pn * tB; return true; }
};
struct SchedWin {
    TileOrder o; const char* A; const char* B; size_t tA, tB; int nlo, skip, boff;
    __device__ __forceinline__ bool next(int i, Unit& u) const { int q; if (!o.tile(i, u.pm, q)) return false; u.pn = q < nlo ? q : q + skip; u.kind = 0;
        u.A = A + (size_t)u.pm * tA; u.B = B + (size_t)(u.pn - boff) * tB; return true; }
};
struct SchedBranch {
    TileOrder o; const char* abase; const char* W; int f8;
    __device__ __forceinline__ bool next(int i, Unit& u) const {
        const int ti = i / 3, k = i - ti * 3; if (!o.tile(ti, u.pm, u.pn)) return false; u.kind = k;
        const int aoff = f8 ? ((k == 0) ? A8_HC : (k == 1 ? A8_SGU : A8_ATT)) : 2 * ((k == 0) ? A_HC : (k == 1 ? A_SGU : A_Q));
        const size_t wb = f8 ? 1 : 2;
        u.A = abase + (size_t)aoff + (size_t)u.pm * (256 * (size_t)LDA * 2); u.B = W + (size_t)k * (1024 * 512 * wb) + (size_t)u.pn * (256 * 512 * wb); return true; }
};
struct SchedMoe {
    TileOrder o; const char* A; const char* B; size_t tA, tB, bexp; int tp1, tp2, tp3, tp4, tp5, tp6, tp7;
    __device__ __forceinline__ bool next(int i, Unit& u) const { if (!o.tile(i, u.pm, u.pn)) return false;
        const int pm = u.pm; const int e = (pm >= tp1) + (pm >= tp2) + (pm >= tp3) + (pm >= tp4) + (pm >= tp5) + (pm >= tp6) + (pm >= tp7);
        u.kind = e; u.A = A + (size_t)pm * tA; u.B = B + (size_t)e * bexp + (size_t)u.pn * tB; return true; }
};

struct SchedTail {
    SchedMoe m; int pm, pn;
    __device__ __forceinline__ bool next(int i, Unit& u) const { if (i != 0) return false; u.pm = pm; u.pn = pn;
        const int e = (pm >= m.tp1) + (pm >= m.tp2) + (pm >= m.tp3) + (pm >= m.tp4) + (pm >= m.tp5) + (pm >= m.tp6) + (pm >= m.tp7);
        u.kind = e; u.A = m.A + (size_t)pm * m.tA; u.B = m.B + (size_t)e * m.bexp + (size_t)pn * m.tB; return true; }
};

struct RowScale {
    const LAS float* tab; const float* part; int p0, p1, p2, p3;
    __device__ __forceinline__ float row(int p, int lrow, int grow, int fq) const {
        const int sl = (p == p0) ? 0 : (p == p1) ? 1 : (p == p2) ? 2 : (p == p3) ? 3 : -1;
        if (sl >= 0) return tab[sl * 256 + lrow];
        const f32x4 q = *(const f32x4*)(part + (size_t)grow * 16 + 4 * fq);
        float sm = (q[0] + q[1]) + (q[2] + q[3]); sm += __shfl_xor(sm, 16); sm += __shfl_xor(sm, 32);
        return __builtin_amdgcn_rsqf(sm * (1.0f / DM) + EPS);
    }
};
struct EpiWin {
    static constexpr bool INPLACE = false; static constexpr bool PERM = true;
    bf16* a; const float* bgate; const LAS float* lbias; float sc; unsigned char* g8; RowScale rsc;
    __device__ __forceinline__ void operator()(const f32x4 (&acc)[2][2][4][2], const Unit& u, int wr, int wc, int fr, int fq) const {
        asm volatile("" : "+v"(fr), "+v"(fq));
        const int row0 = u.pm * BM + wr * 64 + fr, col0 = u.pn * BM + wc * 32 + 8 * fq;
        if (u.pn < 4) {
            const int gc0 = u.pn * HALF + wc * 32 + 8 * fq;
#pragma unroll
            for (int ai = 0; ai < 2; ++ai)
#pragma unroll
                for (int m = 0; m < 4; ++m) {
                    const float sr = rsc.tab ? sc * rsc.row(u.pm, ai * HALF + wr * 64 + m * 16 + fr, row0 + ai * HALF + m * 16, fq) : sc;
                    const float c1 = -sr * LOG2E;
                    f32x4 e0 = acc[ai][1][m][0] * c1, e1 = acc[ai][1][m][1] * c1;
#pragma unroll
                    for (int j = 0; j < 4; ++j) { e0[j] = __builtin_amdgcn_exp2f(e0[j]); e1[j] = __builtin_amdgcn_exp2f(e1[j]); }
                    e0 = e0 + 1.0f; e1 = e1 + 1.0f;
#pragma unroll
                    for (int j = 0; j < 4; ++j) { e0[j] = __builtin_amdgcn_rcpf(e0[j]); e1[j] = __builtin_amdgcn_rcpf(e1[j]); }
                    const f32x4 r0 = acc[ai][0][m][0] * sr * e0, r1 = acc[ai][0][m][1] * sr * e1;
                    u32x4 w; w.x = cvt_pk_bf16(r0[0], r0[1]); w.y = cvt_pk_bf16(r0[2], r0[3]); w.z = cvt_pk_bf16(r1[0], r1[1]); w.w = cvt_pk_bf16(r1[2], r1[3]);
                    *(u32x4*)(a + (size_t)(row0 + ai * HALF + m * 16) * LDA + A_CONV + gc0) = w; }
            return;
        }
        const int act = (u.pn >= 12 && u.pn < 24) ? 2 : ((u.pn >= 4 && u.pn < 8) ? 1 : 0);
        const int dcol = (u.pn < 12) ? col0 : col0 - (6144 - A_V);
        const float qsc = (u.pn == 8 || u.pn == 9) ? 0.125f * LOG2E : 1.0f;
        f32x4 bv[2][2];
#pragma unroll
        for (int bj = 0; bj < 2; ++bj)
#pragma unroll
            for (int n = 0; n < 2; ++n) bv[bj][n] = (act == 2) ? *(const LAS f32x4*)(lbias + (col0 - G_COL0) + bj * HALF + 4 * n) * (-LOG2E) - 8.0f : (f32x4){0.f, 0.f, 0.f, 0.f};
#pragma unroll
        for (int ai = 0; ai < 2; ++ai)
#pragma unroll
            for (int m = 0; m < 4; ++m) { bf16* rowp = a + (size_t)(row0 + ai * HALF + m * 16) * LDA + dcol;
                const float sr = (rsc.tab ? sc * rsc.row(u.pm, ai * HALF + wr * 64 + m * 16 + fr, row0 + ai * HALF + m * 16, fq) : sc) * ((act == 2) ? -LOG2E : qsc);
                u32x4 gw = (u32x4){0u, 0u, 0u, 0u};
#pragma unroll
                for (int bj = 0; bj < 2; ++bj) { f32x4 v0 = acc[ai][bj][m][0] * sr + bv[bj][0], v1 = acc[ai][bj][m][1] * sr + bv[bj][1];
                    if (act == 1) { f32x2 p = gelu_pk((f32x2){v0[0], v0[1]}), q = gelu_pk((f32x2){v0[2], v0[3]}), s = gelu_pk((f32x2){v1[0], v1[1]}), t = gelu_pk((f32x2){v1[2], v1[3]});
                        v0 = (f32x4){p.x, p.y, q.x, q.y}; v1 = (f32x4){s.x, s.y, t.x, t.y}; }
                    if (act == 2) {
                        unsigned q0 = 0u, q1 = 0u;
#pragma unroll
                        for (int j = 0; j < 4; ++j) { q0 = __builtin_amdgcn_cvt_pk_u8_f32(fmaxf(__builtin_amdgcn_rcpf(__builtin_amdgcn_exp2f(v0[j]) + 0.00390625f), 1.0f), j, q0); q1 = __builtin_amdgcn_cvt_pk_u8_f32(fmaxf(__builtin_amdgcn_rcpf(__builtin_amdgcn_exp2f(v1[j]) + 0.00390625f), 1.0f), j, q1); }
                        if (bj == 0) { gw.x = q0; gw.y = q1; }
                        else { gw.z = q0; gw.w = q1;
                            *(u32x4*)(g8 + (size_t)(row0 + ai * HALF + m * 16) * NGATE + (u.pn - 12) * BM + wc * 64 + fq * 16) = gw; }
                    } else {
                    u32x4 w; w.x = cvt_pk_bf16(v0[0], v0[1]); w.y = cvt_pk_bf16(v0[2], v0[3]); w.z = cvt_pk_bf16(v1[0], v1[1]); w.w = cvt_pk_bf16(v1[2], v1[3]);
                    *(u32x4*)(rowp + bj * HALF) = w; } } }
    }
};
struct EpiBf16Plain {
    static constexpr bool INPLACE = false; static constexpr bool PERM = true;
    bf16* O; int ldc; float sc; RowScale csc;
    __device__ __forceinline__ void operator()(const f32x4 (&acc)[2][2][4][2], const Unit& u, int wr, int wc, int fr, int fq) const {
        asm volatile("" : "+v"(fr), "+v"(fq));
        const int row0 = u.pm * BM + wr * 64 + fr, col0 = u.pn * BM + wc * 32 + 8 * fq;
        f32x4 cs[2][2];
#pragma unroll
        for (int bj = 0; bj < 2; ++bj)
#pragma unroll
            for (int n = 0; n < 2; ++n) { cs[bj][n] = (f32x4){sc, sc, sc, sc};
                if (csc.tab) {
#pragma unroll
                    for (int j = 0; j < 4; ++j) cs[bj][n][j] = sc * csc.row(u.pn, bj * HALF + wc * 32 + 8 * fq + 4 * n + j, u.pn * BM + bj * HALF + wc * 32 + 8 * fq + 4 * n + j, fq); } }
#pragma unroll
        for (int ai = 0; ai < 2; ++ai)
#pragma unroll
            for (int m = 0; m < 4; ++m) { bf16* rowp = O + (size_t)(row0 + ai * HALF + m * 16) * ldc + col0;
#pragma unroll
                for (int bj = 0; bj < 2; ++bj) { const f32x4 v0 = acc[ai][bj][m][0] * cs[bj][0], v1 = acc[ai][bj][m][1] * cs[bj][1];
                    u32x4 w; w.x = cvt_pk_bf16(v0[0], v0[1]); w.y = cvt_pk_bf16(v0[2], v0[3]); w.z = cvt_pk_bf16(v1[0], v1[1]); w.w = cvt_pk_bf16(v1[2], v1[3]);
                    *(u32x4*)(rowp + bj * HALF) = w; } }
    }
};
struct EpiSwigluF8 {
    static constexpr bool INPLACE = false; static constexpr bool PERM = true;
    unsigned char* O; int ldc; float si, so; RowScale rsc;
    __device__ __forceinline__ void operator()(const f32x4 (&acc)[2][2][4][2], const Unit& u, int wr, int wc, int fr, int fq) const {
        asm volatile("" : "+v"(fr), "+v"(fq));
        const int row0 = u.pm * BM + wr * 64 + fr, col0 = u.pn * HALF + wc * 32 + 8 * fq;
#pragma unroll
        for (int ai = 0; ai < 2; ++ai)
#pragma unroll
            for (int m = 0; m < 4; ++m) { unsigned char* rowp = O + (size_t)(row0 + ai * HALF + m * 16) * ldc + col0;
                const float sr = rsc.tab ? si * rsc.row(u.pm, ai * HALF + wr * 64 + m * 16 + fr, row0 + ai * HALF + m * 16, fq) : si;
                const float c1 = -sr * LOG2E, c2 = sr * sr * so;
                f32x4 e0 = acc[ai][0][m][0] * c1, e1 = acc[ai][0][m][1] * c1; const f32x4 p0 = acc[ai][0][m][0] * acc[ai][1][m][0] * c2, p1 = acc[ai][0][m][1] * acc[ai][1][m][1] * c2;
#pragma unroll
                for (int j = 0; j < 4; ++j) { e0[j] = __builtin_amdgcn_exp2f(e0[j]); e1[j] = __builtin_amdgcn_exp2f(e1[j]); }
                e0 = e0 + 1.0f; e1 = e1 + 1.0f;
#pragma unroll
                for (int j = 0; j < 4; ++j) { e0[j] = __builtin_amdgcn_rcpf(e0[j]); e1[j] = __builtin_amdgcn_rcpf(e1[j]); }
                const f32x4 r0 = p0 * e0, r1 = p1 * e1;
                u32x2 w; w.x = cvt4_fp8(r0[0], r0[1], r0[2], r0[3]); w.y = cvt4_fp8(r1[0], r1[1], r1[2], r1[3]);
                *(u32x2*)rowp = w; }
    }
};
__device__ __forceinline__ float ub0(unsigned p) { float f; asm("v_cvt_f32_ubyte0 %0, %1" : "=v"(f) : "v"(p)); return f; }
__device__ __forceinline__ float ub1(unsigned p) { float f; asm("v_cvt_f32_ubyte1 %0, %1" : "=v"(f) : "v"(p)); return f; }
__device__ __forceinline__ float ub2(unsigned p) { float f; asm("v_cvt_f32_ubyte2 %0, %1" : "=v"(f) : "v"(p)); return f; }
__device__ __forceinline__ float ub3(unsigned p) { float f; asm("v_cvt_f32_ubyte3 %0, %1" : "=v"(f) : "v"(p)); return f; }
struct EpiBranch {
    static constexpr bool PERM = true, INPLACE = true;
    bf16* a; const unsigned char* g8; int mf8; float osc;
    __device__ __forceinline__ void inplace(f32x4 (&acc)[2][2][4][2], const Unit& u, int wr, int wc, int fr, int fq) const {
        asm volatile("" : "+v"(fr), "+v"(fq));
        const int row0 = u.pm * BM + wr * 64 + fr, col0 = u.pn * BM + wc * 32 + 8 * fq, k = u.kind, gcol = u.pn * BM + wc * 64 + fq * 16;
        if (k < 2) {
#pragma unroll
            for (int ai = 0; ai < 2; ++ai) {
                u32x4 qa[4], qb[4];
#pragma unroll
                for (int m = 0; m < 4; ++m) { const unsigned char* gp = g8 + (size_t)(row0 + ai * HALF + m * 16) * NGATE + k * 1024 + gcol;
                    qa[m] = *(const u32x4*)gp; qb[m] = *(const u32x4*)(gp + 1024); }
#pragma unroll
                for (int m = 0; m < 4; ++m)
#pragma unroll
                    for (int bj = 0; bj < 2; ++bj) { u32x2 x, y; x.x = bj ? qa[m].z : qa[m].x; x.y = bj ? qa[m].w : qa[m].y; y.x = bj ? qb[m].z : qb[m].x; y.y = bj ? qb[m].w : qb[m].y;
                        f32x4 r0, r1;
                        r0[0] = ub0(x.x) * __builtin_amdgcn_rcpf(ub0(y.x)); r0[1] = ub1(x.x) * __builtin_amdgcn_rcpf(ub1(y.x)); r0[2] = ub2(x.x) * __builtin_amdgcn_rcpf(ub2(y.x)); r0[3] = ub3(x.x) * __builtin_amdgcn_rcpf(ub3(y.x));
                        r1[0] = ub0(x.y) * __builtin_amdgcn_rcpf(ub0(y.y)); r1[1] = ub1(x.y) * __builtin_amdgcn_rcpf(ub1(y.y)); r1[2] = ub2(x.y) * __builtin_amdgcn_rcpf(ub2(y.y)); r1[3] = ub3(x.y) * __builtin_amdgcn_rcpf(ub3(y.y));
                        acc[ai][bj][m][0] = acc[ai][bj][m][0] * r0; acc[ai][bj][m][1] = acc[ai][bj][m][1] * r1; }
            }
            return;
        }
#pragma unroll
        for (int ai = 0; ai < 2; ++ai) {
            u32x4 gq[4];
#pragma unroll
            for (int m = 0; m < 4; ++m) gq[m] = *(const u32x4*)(g8 + (size_t)(row0 + ai * HALF + m * 16) * NGATE + 2048 + gcol);
#pragma unroll
            for (int m = 0; m < 4; ++m)
#pragma unroll
                for (int bj = 0; bj < 2; ++bj) { bf16* rowp = a + (size_t)(row0 + ai * HALF + m * 16) * LDA + A_G + col0 + bj * HALF;
                    const f32x4 v0 = acc[ai][bj][m][0], v1 = acc[ai][bj][m][1]; u32x2 g; g.x = bj ? gq[m].z : gq[m].x; g.y = bj ? gq[m].w : gq[m].y;
                    if (mf8) { const f32x4 s0 = v0 * osc, s1 = v1 * osc; u32x2 w8;
                        if (mf8 == 2) { w8.x = cvt4_i8(ub0(g.x) * s0[0], ub1(g.x) * s0[1], ub2(g.x) * s0[2], ub3(g.x) * s0[3]); w8.y = cvt4_i8(ub0(g.y) * s1[0], ub1(g.y) * s1[1], ub2(g.y) * s1[2], ub3(g.y) * s1[3]); } else {
                        w8.x = cvt4_fp8(ub0(g.x) * s0[0], ub1(g.x) * s0[1], ub2(g.x) * s0[2], ub3(g.x) * s0[3]); w8.y = cvt4_fp8(ub0(g.y) * s1[0], ub1(g.y) * s1[1], ub2(g.y) * s1[2], ub3(g.y) * s1[3]); }
                        *(u32x2*)((unsigned char*)a + (size_t)(row0 + ai * HALF + m * 16) * (LDA * 2) + A_G * 2 + col0 + bj * HALF) = w8;
                    } else {
                    u32x4 w;
                    w.x = cvt_pk_bf16(ub0(g.x) * v0[0], ub1(g.x) * v0[1]); w.y = cvt_pk_bf16(ub2(g.x) * v0[2], ub3(g.x) * v0[3]);
                    w.z = cvt_pk_bf16(ub0(g.y) * v1[0], ub1(g.y) * v1[1]); w.w = cvt_pk_bf16(ub2(g.y) * v1[2], ub3(g.y) * v1[3]);
                    *(u32x4*)rowp = w; }
                    acc[ai][bj][m][0] = (f32x4){0.f, 0.f, 0.f, 0.f}; acc[ai][bj][m][1] = (f32x4){0.f, 0.f, 0.f, 0.f}; }
        }
    }
};
struct EpiRes {
    static constexpr bool INPLACE = false; static constexpr bool PERM = true;
    bf16* h; unsigned char* xf8; const float* gain; float* part; float sc; int xo, nrm; float sx8;
    __device__ __forceinline__ void operator()(const f32x4 (&acc)[2][2][4][2], const Unit& u, int wr, int wc, int fr, int fq) const {
        asm volatile("" : "+v"(fr), "+v"(fq));
        const int row0 = u.pm * BM + wr * 64 + fr, col0 = u.pn * BM + wc * 32 + 8 * fq;
        f32x4 gv[2][2];
#pragma unroll
        for (int bj = 0; bj < 2; ++bj)
#pragma unroll
            for (int n = 0; n < 2; ++n) { gv[bj][n] = (f32x4){0.f, 0.f, 0.f, 0.f}; if (xo) gv[bj][n] = *(const f32x4*)(gain + col0 + bj * HALF + 4 * n) * (xo == 2 ? sx8 : F8_SX); }
#pragma unroll
        for (int ai = 0; ai < 2; ++ai) {
            u32x4 bs[4][2];
#pragma unroll
            for (int m = 0; m < 4; ++m)
#pragma unroll
                for (int bj = 0; bj < 2; ++bj) bs[m][bj] = *(const u32x4*)(h + (size_t)(row0 + ai * HALF + m * 16) * DM + col0 + bj * HALF);
#pragma unroll
            for (int m = 0; m < 4; ++m) { const int row = row0 + ai * HALF + m * 16; float ss = 0.f;
#pragma unroll
                for (int bj = 0; bj < 2; ++bj) { const u32x4 b = bs[m][bj]; const size_t off = (size_t)row * DM + col0 + bj * HALF;
                    const f32x4 o0 = (f32x4){bflo(b.x), bfhi(b.x), bflo(b.y), bfhi(b.y)} + acc[ai][bj][m][0] * sc, o1 = (f32x4){bflo(b.z), bfhi(b.z), bflo(b.w), bfhi(b.w)} + acc[ai][bj][m][1] * sc;
                    u32x4 w; w.x = cvt_pk_bf16(o0[0], o0[1]); w.y = cvt_pk_bf16(o0[2], o0[3]); w.z = cvt_pk_bf16(o1[0], o1[1]); w.w = cvt_pk_bf16(o1[2], o1[3]);
                    *(u32x4*)(h + off) = w;
                    if (xo) { const f32x4 x0 = o0 * gv[bj][0], x1 = o1 * gv[bj][1]; u32x2 q;
                        if (xo == 2) { q.x = cvt4_i8(x0[0], x0[1], x0[2], x0[3]); q.y = cvt4_i8(x1[0], x1[1], x1[2], x1[3]); } else { q.x = cvt4_fp8(x0[0], x0[1], x0[2], x0[3]); q.y = cvt4_fp8(x1[0], x1[1], x1[2], x1[3]); }
                        *(u32x2*)(xf8 + off) = q; }
                    if (nrm) ss += ((o0[0] * o0[0] + o0[1] * o0[1]) + (o0[2] * o0[2] + o0[3] * o0[3])) + ((o1[0] * o1[0] + o1[1] * o1[1]) + (o1[2] * o1[2] + o1[3] * o1[3])); }
                if (nrm) { ss += __shfl_xor(ss, 16); ss += __shfl_xor(ss, 32); if (fq == 0) part[(size_t)row * 16 + u.pn * 4 + wc] = ss; } }
            asm volatile("" ::: "memory");
        }
    }
};
struct EpiSwiglu {
    static constexpr bool INPLACE = false; static constexpr bool PERM = true;
    bf16* O; int ldc; RowScale rsc; float si;
    __device__ __forceinline__ void operator()(const f32x4 (&acc)[2][2][4][2], const Unit& u, int wr, int wc, int fr, int fq) const {
        asm volatile("" : "+v"(fr), "+v"(fq));
        const int row0 = u.pm * BM + wr * 64 + fr, col0 = u.pn * HALF + wc * 32 + 8 * fq;
#pragma unroll
        for (int ai = 0; ai < 2; ++ai)
#pragma unroll
            for (int m = 0; m < 4; ++m) { bf16* rowp = O + (size_t)(row0 + ai * HALF + m * 16) * ldc + col0;
                const float sr = (rsc.tab ? rsc.row(u.pm, ai * HALF + wr * 64 + m * 16 + fr, row0 + ai * HALF + m * 16, fq) : 1.0f) * si;
                const float c1 = -sr * LOG2E, c2 = sr * sr;
                f32x4 e0 = acc[ai][0][m][0] * c1, e1 = acc[ai][0][m][1] * c1; const f32x4 p0 = acc[ai][0][m][0] * acc[ai][1][m][0] * c2, p1 = acc[ai][0][m][1] * acc[ai][1][m][1] * c2;
#pragma unroll
                for (int j = 0; j < 4; ++j) { e0[j] = __builtin_amdgcn_exp2f(e0[j]); e1[j] = __builtin_amdgcn_exp2f(e1[j]); }
                e0 = e0 + 1.0f; e1 = e1 + 1.0f;
#pragma unroll
                for (int j = 0; j < 4; ++j) { e0[j] = __builtin_amdgcn_rcpf(e0[j]); e1[j] = __builtin_amdgcn_rcpf(e1[j]); }
                const f32x4 r0 = p0 * e0, r1 = p1 * e1;
                u32x4 w; w.x = cvt_pk_bf16(r0[0], r0[1]); w.y = cvt_pk_bf16(r0[2], r0[3]); w.z = cvt_pk_bf16(r1[0], r1[1]); w.w = cvt_pk_bf16(r1[2], r1[3]);
                *(u32x4*)rowp = w; }
    }
};
}

namespace fa {
using bf16=__hip_bfloat16;
using bf16x8=__attribute__((ext_vector_type(8)))short;
using s16x4=__attribute__((ext_vector_type(4)))short;
using f32x16=__attribute__((ext_vector_type(16)))float;
using u32x4=__attribute__((ext_vector_type(4)))unsigned;
constexpr int BATCH=4,NHEAD=8,SEQ=8192,D=64,DM=5120;
constexpr int NW=8,QBLK=32,UW=4,QB=QBLK*UW,KVBLK=64,NQB=SEQ/QB;
constexpr int ATTN_PITCH=DM, ATTN_UNIT_ROWS=QB;
__device__ __forceinline__ int crow(int r,int hi){return (r&3)+8*(r>>2)+4*hi;}
#define SBAR() __builtin_amdgcn_sched_barrier(0)
typedef const __attribute__((address_space(3))) float* lds_cfptr;
__device__ __forceinline__ void biasmask(f32x16&p0,f32x16&p1,int dj,int qi,int hi,lds_cfptr tbs){
  if(dj<0||dj>8){
    #pragma unroll
    for(int r=0;r<16;++r){p0[r]=-1000.f;p1[r]=-1000.f;}
  } else if(dj<3){ const int base=64*dj+qi-4*hi+63;
    #pragma unroll
    for(int r=0;r<16;++r){ const int i0=base-((r&3)+8*(r>>2)), i1=i0-32; p0[r]+=tbs[i0>191?191:i0]; p1[r]+=tbs[i1>191?191:i1]; }
  }
}

constexpr int NSLOT=3, SLOTB=8192;
constexpr int LDS_K=0, LDS_V=NSLOT*SLOTB, LDS_UNIT=2*NSLOT*SLOTB, LDS_WS=2*LDS_UNIT, LDS_OST=LDS_WS+NW*64*4, LDS_BYTES=LDS_OST+NW*4096;
constexpr float C2=0.125f*1.4426950408889634f;
__device__ __forceinline__ void glds16(const void*gsrc,unsigned lds_dst){unsigned keep;
  asm volatile("s_mov_b32 %0, m0\n\ts_mov_b32 m0, %2\n\ts_nop 0\n\tglobal_load_lds_dwordx4 %1, off\n\ts_mov_b32 m0, %0":"=&s"(keep):"v"(gsrc),"s"(lds_dst):"memory");}
__device__ __forceinline__ float max3f(float a,float b,float c){float r;asm("v_max3_f32 %0, %1, %2, %3":"=v"(r):"v"(a),"v"(b),"v"(c));return r;}
__device__ __forceinline__ float max2f(float a,float b){float r;asm("v_max_f32_e32 %0, %1, %2":"=v"(r):"v"(a),"v"(b));return r;}
__device__ __forceinline__ float fadd_s(float a,float b){float r;asm("v_add_f32_e32 %0, %1, %2":"=v"(r):"v"(a),"v"(b));return r;}
__device__ __forceinline__ float fsub_s(float a,float b){float r;asm("v_sub_f32_e32 %0, %1, %2":"=v"(r):"v"(a),"v"(b));return r;}
typedef float f32x2_t __attribute__((ext_vector_type(2))); typedef __bf16 bf16x2_t __attribute__((ext_vector_type(2)));
__device__ __forceinline__ unsigned cvtpk_s(float lo,float hi){f32x2_t v={lo,hi};bf16x2_t b=__builtin_convertvector(v,bf16x2_t);return __builtin_bit_cast(unsigned,b);}
#define WAIT_BAR(N) asm volatile("s_waitcnt vmcnt(" #N ") lgkmcnt(0)\n\ts_barrier":::"memory")

__device__ __forceinline__ void qkt(f32x16&p0,f32x16&p1,const char*Kslot,const bf16x8*qr,const f32x16&negm,int r32,int hi){
  const char*kb=Kslot+hi*1024+r32*16;
  #pragma unroll
  for(int d0=0;d0<4;++d0){
    const bf16x8 b0=*reinterpret_cast<const bf16x8*>(kb+d0*2048);
    const bf16x8 b1=*reinterpret_cast<const bf16x8*>(kb+d0*2048+512);
    if(d0==0){p0=__builtin_amdgcn_mfma_f32_32x32x16_bf16(b0,qr[0],negm,0,0,0);p1=__builtin_amdgcn_mfma_f32_32x32x16_bf16(b1,qr[0],negm,0,0,0);}
    else{p0=__builtin_amdgcn_mfma_f32_32x32x16_bf16(b0,qr[d0],p0,0,0,0);p1=__builtin_amdgcn_mfma_f32_32x32x16_bf16(b1,qr[d0],p1,0,0,0);}}
}
typedef __attribute__((address_space(3))) const char* lds_cptr;
typedef short v4i16_t __attribute__((ext_vector_type(4)));
__device__ __forceinline__ void kload8(bf16x8*kf,lds_cptr kp){
  kf[0]=*(const __attribute__((address_space(3))) bf16x8*)(kp);      kf[1]=*(const __attribute__((address_space(3))) bf16x8*)(kp+512);
  kf[2]=*(const __attribute__((address_space(3))) bf16x8*)(kp+2048); kf[3]=*(const __attribute__((address_space(3))) bf16x8*)(kp+2560);
  kf[4]=*(const __attribute__((address_space(3))) bf16x8*)(kp+4096); kf[5]=*(const __attribute__((address_space(3))) bf16x8*)(kp+4608);
  kf[6]=*(const __attribute__((address_space(3))) bf16x8*)(kp+6144); kf[7]=*(const __attribute__((address_space(3))) bf16x8*)(kp+6656);
}
__device__ __forceinline__ void kload2(bf16x8*kf,lds_cptr kp,int j){ kf[2*j]=*(const __attribute__((address_space(3))) bf16x8*)(kp+j*2048); kf[2*j+1]=*(const __attribute__((address_space(3))) bf16x8*)(kp+j*2048+512); }
__device__ __forceinline__ s16x4 vtr(lds_cptr p){ return __builtin_bit_cast(s16x4,__builtin_amdgcn_ds_read_tr16_b64_v4i16((__attribute__((address_space(3))) v4i16_t*)p)); }
__device__ __forceinline__ float rowmax(const f32x16&p0,const f32x16&p1){
  float a=max3f(p0[0],p0[1],p1[0]),b=max3f(p0[2],p0[3],p1[1]);a=max3f(a,p1[2],p1[3]);
  #pragma unroll
  for(int r=4;r<16;r+=4){a=max3f(a,p0[r],p0[r+1]);b=max3f(b,p0[r+2],p0[r+3]);a=max3f(a,p1[r],p1[r+1]);b=max3f(b,p1[r+2],p1[r+3]);}
  const float m=max2f(a,b);
  auto rr=__builtin_amdgcn_permlane32_swap(__float_as_uint(m),__float_as_uint(m),false,false);
  return max2f(__uint_as_float(rr[0]),__uint_as_float(rr[1]));
}
__device__ __forceinline__ void pv(f32x16*o,int vb,bf16x8 pa0,bf16x8 pa1,bf16x8 pa2,bf16x8 pa3){
  #pragma unroll
  for(int d0=0;d0<2;++d0){s16x4 lo[4],hi[4];
    #pragma unroll
    for(int ks=0;ks<4;++ks){
      asm volatile("ds_read_b64_tr_b16 %0,%1 offset:%c2":"=&v"(lo[ks]):"v"(vb),"i"(d0*4096+ks*1024):"memory");
      asm volatile("ds_read_b64_tr_b16 %0,%1 offset:%c2":"=&v"(hi[ks]):"v"(vb),"i"(d0*4096+ks*1024+512):"memory");}
    asm volatile("s_waitcnt lgkmcnt(0)":::"memory");SBAR();
    #define PK(k) (bf16x8){lo[k][0],lo[k][1],lo[k][2],lo[k][3],hi[k][0],hi[k][1],hi[k][2],hi[k][3]}
    o[d0]=__builtin_amdgcn_mfma_f32_32x32x16_bf16(pa0,PK(0),o[d0],0,0,0);
    o[d0]=__builtin_amdgcn_mfma_f32_32x32x16_bf16(pa1,PK(1),o[d0],0,0,0);
    o[d0]=__builtin_amdgcn_mfma_f32_32x32x16_bf16(pa2,PK(2),o[d0],0,0,0);
    o[d0]=__builtin_amdgcn_mfma_f32_32x32x16_bf16(pa3,PK(3),o[d0],0,0,0);
    #undef PK
  }
}

#ifndef ATTN_STORE16
#define ATTN_STORE16(p,v) (*(u32x4*)(p)=(v))
#endif
template<int THRL> __device__ __forceinline__ void attn_unit(int b,int h0,int c0,const bf16*Q,const bf16*__restrict__ K,const bf16*__restrict__ V,bf16*O,unsigned char*O8,char*shm,lds_cfptr tbs){
  int tid_=threadIdx.x; asm volatile("":"+v"(tid_));
  const int tid=tid_,lane=tid&63,r32=lane&31,hi=lane>>5; const int wid=__builtin_amdgcn_readfirstlane(tid>>6);
  const int U=wid>>2, w4=wid&3, ub=U*LDS_UNIT; const int h=h0+U; tbs+=h*192;
  const long rowbase=(long)b*SEQ; const int q0=c0*KVBLK; const int T0=c0>8?c0-8:0;
  const bf16*Qw=Q+(rowbase+q0+w4*QBLK)*DM+h*D;
  const bf16*Kh=K+(rowbase+(long)T0*KVBLK)*DM+h*D,*Vh=V+(rowbase+(long)T0*KVBLK)*DM+h*D;
  const unsigned lds0=(unsigned)(uintptr_t)shm;
  float*wsf=(float*)(shm+LDS_WS)+wid*64;
  const bf16*ksrc=Kh+(long)lane*DM+w4*8;
  const bf16*vsrc=Vh+(long)(16*w4+(lane>>2))*DM+(lane&3)*8;
  const unsigned kdst=lds0+ub+LDS_K+w4*1024, vdst=lds0+ub+LDS_V+w4*1024;
  #define DMA_K(t,slot) do{ glds16(ksrc+(long)(t)*KVBLK*DM,(unsigned)__builtin_amdgcn_readfirstlane(kdst+(slot))); glds16(ksrc+(long)(t)*KVBLK*DM+32,(unsigned)__builtin_amdgcn_readfirstlane(kdst+(slot)+4096)); }while(0)
  #define DMA_V(t,slot) do{ glds16(vsrc+(long)(t)*KVBLK*DM,(unsigned)__builtin_amdgcn_readfirstlane(vdst+(slot))); glds16(vsrc+(long)(t)*KVBLK*DM+32,(unsigned)__builtin_amdgcn_readfirstlane(vdst+(slot)+4096)); }while(0)
  const int vb0=(int)(lds0+ub+LDS_V)+((lane>>4)&1)*32+(lane&3)*8+(4*hi+((lane&15)>>2))*64;
  const char*Kbase=shm+ub+LDS_K; bf16x8 kf[8];
  const lds_cptr shm3=(lds_cptr)shm+ub; const lds_cptr kp0=shm3+LDS_K+hi*1024+r32*16; const lds_cptr vp0=shm3+LDS_V+((lane>>4)&1)*32+(lane&3)*8+(4*hi+((lane&15)>>2))*64;
  const int NT=(c0+2-T0)<4?4:(c0+2-T0);
  DMA_K(0,0);DMA_V(0,0);DMA_K(1,SLOTB);
  bf16x8 qr[4];
  #pragma unroll
  for(int d0=0;d0<4;++d0)qr[d0]=*reinterpret_cast<const bf16x8*>(&Qw[(long)r32*DM+d0*16+hi*8]);
  float mhat=0.f,l_reg=0.f;f32x16 o[2];o[0]=f32x16{};o[1]=f32x16{};f32x16 negm=f32x16{};asm volatile("":"+v"(negm));
  const int cw=c0+(w4>>1), qi=32*(w4&1)+r32;
  #define CMASK(P0,P1,t) biasmask(P0,P1,cw-(T0+(t)),qi,hi,tbs)
  bool resc=false;
  #define START(P0,P1) do{ const float rm=rowmax(P0,P1); resc=false; \
    { const float dl=rm; mhat=fadd_s(mhat,dl); \
      _Pragma("unroll") for(int r=0;r<16;++r){P0[r]=fsub_s(P0[r],dl);P1[r]=fsub_s(P1[r],dl);} \
      _Pragma("unroll") for(int r=0;r<16;++r)negm[r]=-mhat; asm volatile("":"+v"(negm)); } \
    _Pragma("unroll") for(int r=0;r<16;++r)P0[r]=__builtin_amdgcn_exp2f(P0[r]); }while(0)
  #define RESC() do{ if(resc){ asm volatile("s_waitcnt lgkmcnt(0)":::"memory"); \
      _Pragma("unroll") for(int d_=0;d_<2;++d_) _Pragma("unroll") for(int r=0;r<16;++r)o[d_][r]*=wsf[crow(r,hi)]; } }while(0)
  f32x16 pA0,pA1,pB0,pB1;
  int sl_prev=0,sl_cur=0,sl_next=SLOTB;
  #define ROT() do{sl_prev=sl_cur;sl_cur=sl_next;sl_next=(sl_next==(NSLOT-1)*SLOTB)?0:sl_next+SLOTB;}while(0)
  DMA_K(2,2*SLOTB);
  WAIT_BAR(6);
  qkt(pA0,pA1,Kbase,qr,negm,r32,hi);asm volatile("s_nop 15\n\ts_nop 7":"+v"(pA0),"+v"(pA1));CMASK(pA0,pA1,0);
  START(pA0,pA1);
  _Pragma("unroll") for(int r=0;r<16;++r)pA1[r]=__builtin_amdgcn_exp2f(pA1[r]);
  WAIT_BAR(0);
  DMA_K(3,0);DMA_V(1,SLOTB);
  ROT();
  kload8(kf,kp0+sl_cur);
  WAIT_BAR(4);
  s16x4 vlo[8],vhi[8]; u32x4 pw0,pw1,pw2,pw3;
  #define PKW(P,B) cvtpk_s(P[B],P[B+1])
  #define PAF(k) __builtin_bit_cast(bf16x8,pw##k)
  #define VFR(i) (bf16x8){vlo[i][0],vlo[i][1],vlo[i][2],vlo[i][3],vhi[i][0],vhi[i][1],vhi[i][2],vhi[i][3]}
  #define PIN(x) asm volatile("":"+v"(x))
  #define MX3(a,b,c) __builtin_fmaxf(__builtin_fmaxf((a),(b)),(c))
  #define GAPA(MF,A0,A1,A2,A3,W0,W1,PW) do{ MF; sacc+=A0; sacc+=A1; sacc+=A2; sacc+=A3; PIN(sacc); W0; W1; PIN(PW); SBAR(); }while(0)
  #define EX(v) __builtin_amdgcn_exp2f(v)
  #define GAPB(MF,X,B) do{ MF; X[B]=EX(X[B]); X[B+1]=EX(X[B+1]); X[B+2]=EX(X[B+2]); X[B+3]=EX(X[B+3]); PIN(X); SBAR(); }while(0)
  #define VRD(i) do{ vlo[i]=vtr(vp_+(((i)>>2)*4096+((i)&3)*1024)); vhi[i]=vtr(vp_+(((i)>>2)*4096+((i)&3)*1024+512)); }while(0)
  #define KRD(G,j) do{ if(G){ kload2(kf,kp0+sl_next,j); SBAR(); } }while(0)
  #define STEP(C0,C1,P0,P1,t,GK,GV,GL) do{ SBAR(); \
    const lds_cptr vp_=vp0+sl_prev; \
    VRD(0); SBAR(); float sacc=(P0[0]+P0[1]); \
    GAPA(C0=__builtin_amdgcn_mfma_f32_32x32x16_bf16(kf[0],qr[0],negm,0,0,0), P0[2],P0[3],P0[4],P0[5],     pw0[0]=PKW(P0,0), pw0[1]=PKW(P0,2), pw0); \
    VRD(4); SBAR(); GAPA(C1=__builtin_amdgcn_mfma_f32_32x32x16_bf16(kf[1],qr[0],negm,0,0,0), P0[6],P0[7],P0[8],P0[9],     pw0[2]=PKW(P0,4), pw0[3]=PKW(P0,6), pw0); \
    VRD(1); SBAR(); GAPA(C0=__builtin_amdgcn_mfma_f32_32x32x16_bf16(kf[2],qr[1],C0,0,0,0),   P0[10],P0[11],P0[12],P0[13], pw1[0]=PKW(P0,8), pw1[1]=PKW(P0,10), pw1); \
    VRD(5); SBAR(); GAPA(C1=__builtin_amdgcn_mfma_f32_32x32x16_bf16(kf[3],qr[1],C1,0,0,0),   P0[14],P0[15],P1[0],P1[1],   pw1[2]=PKW(P0,12),pw1[3]=PKW(P0,14), pw1); \
    VRD(2); SBAR(); GAPA(C0=__builtin_amdgcn_mfma_f32_32x32x16_bf16(kf[4],qr[2],C0,0,0,0),   P1[2],P1[3],P1[4],P1[5],     pw2[0]=PKW(P1,0), pw2[1]=PKW(P1,2), pw2); \
    VRD(6); SBAR(); GAPA(C1=__builtin_amdgcn_mfma_f32_32x32x16_bf16(kf[5],qr[2],C1,0,0,0),   P1[6],P1[7],P1[8],P1[9],     pw2[2]=PKW(P1,4), pw2[3]=PKW(P1,6), pw2); \
    VRD(3); SBAR(); GAPA(C0=__builtin_amdgcn_mfma_f32_32x32x16_bf16(kf[6],qr[3],C0,0,0,0),   P1[10],P1[11],P1[12],P1[13], pw3[0]=PKW(P1,8), pw3[1]=PKW(P1,10), pw3); \
    VRD(7); SBAR(); GAPA(C1=__builtin_amdgcn_mfma_f32_32x32x16_bf16(kf[7],qr[3],C1,0,0,0),   P1[14],P1[15],0.f,0.f,       pw3[2]=PKW(P1,12),pw3[3]=PKW(P1,14), pw3); \
    l_reg+=sacc; \
    if(GK){DMA_K((t)+3,sl_cur);} if(GV){DMA_V((t)+1,sl_next);} \
    CMASK(C0,C1,t); \
    { float a=MX3(C0[0],C0[1],C1[0]),b=MX3(C0[2],C0[3],C1[1]); a=MX3(a,C1[2],C1[3]); \
      _Pragma("unroll") for(int r=4;r<16;r+=4){a=MX3(a,C0[r],C0[r+1]);b=MX3(b,C0[r+2],C0[r+3]);a=MX3(a,C1[r],C1[r+1]);b=MX3(b,C1[r+2],C1[r+3]);} \
      float rm=__builtin_fmaxf(a,b); { auto rr=__builtin_amdgcn_permlane32_swap(__float_as_uint(rm),__float_as_uint(rm),false,false); rm=__builtin_fmaxf(__uint_as_float(rr[0]),__uint_as_float(rr[1])); } \
      resc=false; \
      if(__builtin_expect(__any(rm>(float)THRL),0)){ const float dl=__builtin_fmaxf(rm,0.f); mhat+=dl; \
        _Pragma("unroll") for(int r=0;r<16;++r){C0[r]-=dl;C1[r]-=dl;} \
        _Pragma("unroll") for(int r=0;r<16;++r)negm[r]=-mhat; asm volatile("":"+v"(negm)); \
        const float f=__builtin_amdgcn_exp2f(-dl); l_reg*=f; if(hi==0)wsf[r32]=f; resc=true; } } \
    SBAR(); \
    GAPB(o[0]=__builtin_amdgcn_mfma_f32_32x32x16_bf16(PAF(0),VFR(0),o[0],0,0,0), C0,0); \
    GAPB(o[1]=__builtin_amdgcn_mfma_f32_32x32x16_bf16(PAF(0),VFR(4),o[1],0,0,0), C0,4); \
    KRD(GL,0); GAPB(o[0]=__builtin_amdgcn_mfma_f32_32x32x16_bf16(PAF(1),VFR(1),o[0],0,0,0), C0,8); \
    KRD(GL,1); GAPB(o[1]=__builtin_amdgcn_mfma_f32_32x32x16_bf16(PAF(1),VFR(5),o[1],0,0,0), C0,12); \
    KRD(GL,2); GAPB(o[0]=__builtin_amdgcn_mfma_f32_32x32x16_bf16(PAF(2),VFR(2),o[0],0,0,0), C1,0); \
    KRD(GL,3); GAPB(o[1]=__builtin_amdgcn_mfma_f32_32x32x16_bf16(PAF(2),VFR(6),o[1],0,0,0), C1,4); \
    GAPB(o[0]=__builtin_amdgcn_mfma_f32_32x32x16_bf16(PAF(3),VFR(3),o[0],0,0,0), C1,8); \
    GAPB(o[1]=__builtin_amdgcn_mfma_f32_32x32x16_bf16(PAF(3),VFR(7),o[1],0,0,0), C1,12); \
    }while(0)
  int t=1;
  for(;t+5<NT;t+=2){
    STEP(pB0,pB1,pA0,pA1,t,true,true,true);     WAIT_BAR(4); RESC(); ROT();
    STEP(pA0,pA1,pB0,pB1,t+1,true,true,true);   WAIT_BAR(4); RESC(); ROT();
  }
  #define ENDW(tt) do{ if((tt)+3<NT){WAIT_BAR(4);} else if((tt)+2<NT){WAIT_BAR(2);} else {WAIT_BAR(0);} }while(0)
  for(;t+1<NT;t+=2){
    STEP(pB0,pB1,pA0,pA1,t,(t+3<NT),(t+1<NT),(t+1<NT));       ENDW(t);   RESC(); ROT();
    STEP(pA0,pA1,pB0,pB1,t+1,(t+4<NT),(t+2<NT),(t+2<NT));     ENDW(t+1); RESC(); ROT();
  }
  STEP(pB0,pB1,pA0,pA1,NT-1,false,false,false); RESC();
  { float sacc=pB0[0]+pB0[1]; _Pragma("unroll") for(int r=2;r<16;++r)sacc+=pB0[r]; _Pragma("unroll") for(int r=0;r<16;++r)sacc+=pB1[r]; l_reg+=sacc;
    pw0=(u32x4){PKW(pB0,0),PKW(pB0,2),PKW(pB0,4),PKW(pB0,6)};pw1=(u32x4){PKW(pB0,8),PKW(pB0,10),PKW(pB0,12),PKW(pB0,14)};pw2=(u32x4){PKW(pB1,0),PKW(pB1,2),PKW(pB1,4),PKW(pB1,6)};pw3=(u32x4){PKW(pB1,8),PKW(pB1,10),PKW(pB1,12),PKW(pB1,14)};
    SBAR(); pv(o,vb0+sl_cur,PAF(0),PAF(1),PAF(2),PAF(3)); }
  #undef PKW
  #undef PAF
  #undef VFR
  #undef PIN
  #undef MX3
  #undef GAPA
  #undef GAPB
  #undef EX
  #undef VRD
  #undef KRD
  #undef STEP
  #undef ENDW
  {auto rr=__builtin_amdgcn_permlane32_swap(__float_as_uint(l_reg),__float_as_uint(l_reg),false,false);l_reg=__uint_as_float(rr[0])+__uint_as_float(rr[1]);}
  if(hi==0)wsf[32+r32]=l_reg;asm volatile("s_waitcnt lgkmcnt(0)":::"memory");
  float rli[16];
  #pragma unroll
  for(int r=0;r<16;++r)rli[r]=__builtin_amdgcn_rcpf(wsf[32+crow(r,hi)]);
  if(O8){ unsigned char*stg8=(unsigned char*)(shm+LDS_OST)+wid*4096;
    unsigned char*O8w=O8+(rowbase+q0+w4*QBLK)*(long)(2*DM)+h*D;
    #pragma unroll
    for(int r=0;r<16;++r){const int orow=crow(r,hi); const float sc_=rli[r]*F8_SX;
      const unsigned pk=(unsigned)__builtin_amdgcn_cvt_pk_fp8_f32(clamp448(o[0][r]*sc_),clamp448(o[1][r]*sc_),0,false);
      stg8[orow*64+r32]=(unsigned char)(pk&0xffu); stg8[orow*64+32+r32]=(unsigned char)((pk>>8)&0xffu);}
    asm volatile("s_waitcnt lgkmcnt(0)":::"memory");
    #pragma unroll
    for(int i=0;i<2;++i){const int row=i*16+(lane>>2),ch=lane&3; const u32x4 v=*(const u32x4*)(stg8+row*64+ch*16); ATTN_STORE16(O8w+(long)row*(2*DM)+ch*16,v);} }
  else
  { bf16*Ow=O+(rowbase+q0+w4*QBLK)*DM+h*D;
    bf16*stg=(bf16*)(shm+LDS_OST)+wid*2048;
    #pragma unroll
    for(int r=0;r<16;++r){const int orow=crow(r,hi);
      #pragma unroll
      for(int d0=0;d0<2;++d0)stg[orow*64+d0*32+r32]=__float2bfloat16(o[d0][r]*rli[r]);}
    asm volatile("s_waitcnt lgkmcnt(0)":::"memory");
    #pragma unroll
    for(int i=0;i<4;++i){const int row=i*8+(lane>>3),ch=lane&7; const u32x4 v=*(const u32x4*)(stg+row*64+ch*8); ATTN_STORE16(Ow+(long)row*DM+ch*8,v);} }
  asm volatile("s_waitcnt lgkmcnt(0)\n\ts_barrier":::"memory");
  #undef DMA_K
  #undef DMA_V
  #undef CMASK
  #undef START
  #undef RESC
  #undef ROT
}
constexpr int ATTN_LDS_BYTES=LDS_BYTES;
struct AttnTensors { const bf16* Q; const bf16* K; const bf16* V; bf16* O; unsigned char* O8; };
template<int THRL=8> __device__ __forceinline__ void attn_phase(char*lds,const AttnTensors&T,int vcu,int nwg,lds_cfptr tab){
  const int per=(BATCH*(NHEAD/2)*(SEQ/QB))/nwg;
  for(int i=0;i<per;++i){ const int u=vcu*per+i, bhp=u/(SEQ/QB), g=u%(SEQ/QB); attn_unit<THRL>(bhp/(NHEAD/2),(bhp%(NHEAD/2))*2,g*2,T.Q,T.K,T.V,T.O,T.O8,lds,tab); }
}
#undef SBAR
#undef WAIT_BAR
}
static_assert(fa::DM == LDA && fa::ATTN_LDS_BYTES <= ATTN_TAB_OFF, "attention body geometry");
struct Args { const float* in[26]; float* out; unsigned char* ws; int ph_lo, ph_hi; };
struct Frame {
    LAS unsigned char* lds; int tid, lane, wave, G;
    int cvG, cvId;
    float* out; unsigned char* ws; unsigned* ctl;
    unsigned zoff;
    __device__ __forceinline__ const float* inp(int i) const { unsigned zo = zoff; asm volatile("" : "+s"(zo));
        const LAS unsigned* p = (const LAS unsigned*)(lds + LDSCTL_OFF + 256 + 8 * i + zo);
        const unsigned lo = __builtin_amdgcn_readfirstlane(p[0]), hi = __builtin_amdgcn_readfirstlane(p[1]); return (const float*)(const GAS float*)(((unsigned long long)hi << 32) | lo); }
    __device__ __forceinline__ void rethread() { int t = threadIdx.x; asm volatile("" : "+v"(t)); tid = t; lane = t & 63; wave = __builtin_amdgcn_readfirstlane(t >> 6);
        unsigned wl = __builtin_amdgcn_readfirstlane((unsigned)(unsigned long long)ws), wh = __builtin_amdgcn_readfirstlane((unsigned)((unsigned long long)ws >> 32));
        unsigned ol = __builtin_amdgcn_readfirstlane((unsigned)(unsigned long long)out), oh = __builtin_amdgcn_readfirstlane((unsigned)((unsigned long long)out >> 32));
        unsigned z = 0u;
        asm volatile("" : "+s"(wl), "+s"(wh), "+s"(ol), "+s"(oh), "+s"(z)); zoff = z;
        ws = (unsigned char*)(GAS unsigned char*)(((unsigned long long)wh << 32) | wl); out = (float*)(GAS float*)(((unsigned long long)oh << 32) | ol); ctl = (unsigned*)ws; }
};
enum { I_X = 0, I_MIXG, I_WIN, I_BGATE, I_DWW, I_DWB, I_CLNG, I_CLNB, I_COUTW, I_SLNG, I_SLNB, I_SWS, I_SBS, I_SOUTW, I_RELB, I_AOUTW, I_WOUT, I_FFNG, I_FWG, I_FWU, I_FWD, I_ROUTER, I_MWG, I_MWU, I_MWD, I_FING };

struct DstPlain { int off; __device__ __forceinline__ int operator()(int n) const { return n + off; } };
struct DstGU { int half; __device__ __forceinline__ int operator()(int n) const { return (n >> 7) * 256 + (n & 127) + half * 128; } };
template <int Q, class DstOf>
__device__ __forceinline__ void cvt_matrix_t(const Frame& F, const float* src, int ld_src, int N, int K, void* dstv, const DstOf drow, float scale, int& tbase, const float* ks = nullptr) {
    constexpr bool F8 = Q != 0; constexpr int P = F8 ? 136 : 264;
    LAS unsigned char* T = (LAS unsigned char*)F.lds;
    const int nkb = K >> 7, ntiles = (N >> 6) * nkb;
    int first = F.cvId - (tbase % F.cvG); if (first < 0) first += F.cvG;
    const int nq = F.tid & 15, kq = F.tid >> 4;
    f32x4 v[4], kg = (f32x4){1.f, 1.f, 1.f, 1.f};
    if (first < ntiles) { const int nb = first / nkb, kb = first - nb * nkb; const float* sp = src + nb * 64 + (size_t)(kb * 128) * ld_src;
#pragma unroll
        for (int i = 0; i < 4; ++i) v[i] = *(const f32x4*)(sp + (size_t)(kq * 4 + i) * ld_src + nq * 4);
        if (ks) kg = *(const f32x4*)(ks + kb * 128 + kq * 4); }
    for (int id = first; id < ntiles; id += F.cvG) {
        const int nb = id / nkb, kb = id - nb * nkb, n0 = nb * 64, k0 = kb * 128;
        const int d0 = drow(n0);
        const f32x4 sk = kg * scale;
#pragma unroll
        for (int j = 0; j < 4; ++j) {
            const float x0 = v[0][j] * sk[0], x1 = v[1][j] * sk[1], x2 = v[2][j] * sk[2], x3 = v[3][j] * sk[3];
            if (F8) *(LAS unsigned*)(T + (nq * 4 + j) * P + kq * 4) = (Q == 2) ? cvt4_i8(x0, x1, x2, x3) : cvt4_fp8(x0, x1, x2, x3);
            else { u32x2 w; w.x = cvt_pk_bf16(x0, x1); w.y = cvt_pk_bf16(x2, x3); *(LAS u32x2*)(T + (nq * 4 + j) * P + kq * 8) = w; }
        }
        const int nid = id + F.cvG;
        if (nid < ntiles) { const int nb2 = nid / nkb, kb2 = nid - nb2 * nkb; const float* sp = src + nb2 * 64 + (size_t)(kb2 * 128) * ld_src;
#pragma unroll
            for (int i = 0; i < 4; ++i) v[i] = *(const f32x4*)(sp + (size_t)(kq * 4 + i) * ld_src + nq * 4);
            if (ks) kg = *(const f32x4*)(ks + kb2 * 128 + kq * 4); }
        __syncthreads();
        if (F8) { const int n = F.tid >> 3, kc = F.tid & 7;
            const u32x2 w0 = *(const LAS u32x2*)(T + n * P + kc * 16), w1 = *(const LAS u32x2*)(T + n * P + kc * 16 + 8);
            u32x4 w; w.x = w0.x; w.y = w0.y; w.z = w1.x; w.w = w1.y;
            *(u32x4*)((unsigned char*)dstv + (size_t)(d0 + n) * K + k0 + kc * 16) = w;
        } else {
#pragma unroll
            for (int p = 0; p < 2; ++p) { const int n = p * 32 + (F.tid >> 4), kc = F.tid & 15;
                const u32x2 w0 = *(const LAS u32x2*)(T + n * P + kc * 16), w1 = *(const LAS u32x2*)(T + n * P + kc * 16 + 8);
                u32x4 w; w.x = w0.x; w.y = w0.y; w.z = w1.x; w.w = w1.y;
                *(u32x4*)((bf16*)dstv + (size_t)(d0 + n) * K + k0 + kc * 8) = w; }
        }
        __syncthreads();
    }
    tbase += ntiles;
}
template <class DstOf>
__device__ __forceinline__ void cvt_matrix(const Frame& F, const float* src, int ld_src, int N, int K, bf16* dst, const DstOf drow, int& tbase, const float* ks = nullptr) { cvt_matrix_t<0>(F, src, ld_src, N, K, dst, drow, 1.0f, tbase, ks); }
template <class DstOf>
__device__ __forceinline__ void cvt_matrix_f8(const Frame& F, const float* src, int ld_src, int N, int K, unsigned char* dst, const DstOf drow, float scale, int& tbase) { cvt_matrix_t<1>(F, src, ld_src, N, K, dst, drow, scale, tbase); }
template <class DstOf>
__device__ __forceinline__ void cvt_matrix_i8(const Frame& F, const float* src, int ld_src, int N, int K, unsigned char* dst, const DstOf drow, float scale, int& tbase) { cvt_matrix_t<2>(F, src, ld_src, N, K, dst, drow, scale, tbase); }
__device__ __forceinline__ void cvt_moe_layer(const Frame& F, int mi, int& tb, int e_lo, int e_hi) {
    for (int e = e_lo; e < e_hi; ++e) {
        const size_t so = ((size_t)mi * NEXP + e) * (size_t)DM * DFE;
        unsigned char* gu = F.ws + WS_MGU + ((size_t)mi * NEXP + e) * 2 * DFE * DM;
        if (I8_UP) { cvt_matrix_i8(F, F.inp(I_MWG) + so, DFE, DFE, DM, gu, DstGU{0}, I8_SW, tb); cvt_matrix_i8(F, F.inp(I_MWU) + so, DFE, DFE, DM, gu, DstGU{1}, I8_SW, tb); }
        else { cvt_matrix_f8(F, F.inp(I_MWG) + so, DFE, DFE, DM, gu, DstGU{0}, F8_SW, tb);
        cvt_matrix_f8(F, F.inp(I_MWU) + so, DFE, DFE, DM, gu, DstGU{1}, F8_SW, tb); }
        cvt_matrix_f8(F, F.inp(I_MWD) + so, DM, DM, DFE, F.ws + WS_MD + ((size_t)mi * NEXP + e) * DM * DFE, DstPlain{0}, F8_SW, tb);
    }
}
__device__ __forceinline__ void prologue_convert(const Frame& F) {
    int tb = 0;
    for (int l = 0; l < DEPTH; ++l) {
        const float* win = F.inp(I_WIN) + (size_t)l * DM * NIN;
        bf16* wm = (bf16*)(F.ws + WS_WIN) + (size_t)l * NMAIN * DM;
        if ((l >= F8_WIN_FROM || I8_WIN_ALL) && I8_WIN) {
            cvt_matrix_i8(F, win, NIN, 512, DM, (unsigned char*)wm, DstGU{0}, I8_SW, tb);
            cvt_matrix_i8(F, win + 512, NIN, 512, DM, (unsigned char*)wm, DstGU{1}, I8_SW, tb);
            cvt_matrix_i8(F, win + 1024, NIN, 2048, DM, (unsigned char*)wm, DstPlain{1024}, I8_SW, tb);
            cvt_matrix_i8(F, win + 3584, NIN, 3072, DM, (unsigned char*)wm, DstPlain{3072}, I8_SW, tb);
            cvt_matrix_i8(F, win + 3072, NIN, 512, DM, (unsigned char*)wm, DstPlain{6144}, I8_SW, tb);
        } else if (l >= F8_WIN_FROM) {
            cvt_matrix_f8(F, win, NIN, 512, DM, (unsigned char*)wm, DstGU{0}, F8_SW, tb);
            cvt_matrix_f8(F, win + 512, NIN, 512, DM, (unsigned char*)wm, DstGU{1}, F8_SW, tb);
            cvt_matrix_f8(F, win + 1024, NIN, 2048, DM, (unsigned char*)wm, DstPlain{1024}, F8_SW, tb);
            cvt_matrix_f8(F, win + 3584, NIN, 3072, DM, (unsigned char*)wm, DstPlain{3072}, F8_SW, tb);
            cvt_matrix_f8(F, win + 3072, NIN, 512, DM, (unsigned char*)wm, DstPlain{6144}, F8_SW, tb);
        } else {
        const float* mg = F.inp(I_MIXG) + l * DM;
        cvt_matrix(F, win, NIN, 512, DM, wm, DstGU{0}, tb, mg);
        cvt_matrix(F, win + 512, NIN, 512, DM, wm, DstGU{1}, tb, mg);
        cvt_matrix(F, win + 1024, NIN, 2048, DM, wm, DstPlain{1024}, tb, mg);
        if (l >= F8_GATE_FROM && I8_WIN) cvt_matrix_i8(F, win + 3584, NIN, 3072, DM, F.ws + WS_WG8 + (size_t)l * WS_WG8_STEP, DstPlain{0}, I8_SW, tb);
        else if (l >= F8_GATE_FROM) cvt_matrix_f8(F, win + 3584, NIN, 3072, DM, F.ws + WS_WG8 + (size_t)l * WS_WG8_STEP, DstPlain{0}, F8_SW, tb);
        else cvt_matrix(F, win + 3584, NIN, 3072, DM, wm, DstPlain{3072}, tb, mg);
        cvt_matrix(F, win + 3072, NIN, 512, DM, wm, DstPlain{6144}, tb, mg);
        }
        if (l >= F8_BR_FROM) { unsigned char* wb8 = (unsigned char*)((bf16*)(F.ws + WS_WBR) + (size_t)(l * 3) * DM * 512);
        cvt_matrix_t<1>(F, F.inp(I_COUTW) + (size_t)l * 512 * DM, DM, DM, 512, wb8, DstPlain{0}, F8_SW, tb);
        cvt_matrix_t<1>(F, F.inp(I_SOUTW) + (size_t)l * 512 * DM, DM, DM, 512, wb8 + (size_t)DM * 512, DstPlain{0}, F8_SW, tb);
        cvt_matrix_t<1>(F, F.inp(I_AOUTW) + (size_t)l * 512 * DM, DM, DM, 512, wb8 + (size_t)2 * DM * 512, DstPlain{0}, F8_SW, tb);
        } else {
        cvt_matrix_t<0>(F, F.inp(I_COUTW) + (size_t)l * 512 * DM, DM, DM, 512, (bf16*)(F.ws + WS_WBR) + (size_t)(l * 3 + 0) * DM * 512, DstPlain{0}, 1.0f / 256.0f, tb);
        cvt_matrix_t<0>(F, F.inp(I_SOUTW) + (size_t)l * 512 * DM, DM, DM, 512, (bf16*)(F.ws + WS_WBR) + (size_t)(l * 3 + 1) * DM * 512, DstPlain{0}, 1.0f / 256.0f, tb);
        cvt_matrix_t<0>(F, F.inp(I_AOUTW) + (size_t)l * 512 * DM, DM, DM, 512, (bf16*)(F.ws + WS_WBR) + (size_t)(l * 3 + 2) * DM * 512, DstPlain{0}, 1.0f / 256.0f, tb); }
        if (l >= I8_WOUT_FROM) cvt_matrix_i8(F, F.inp(I_WOUT) + (size_t)l * DM * DM, DM, DM, DM, (unsigned char*)((bf16*)(F.ws + WS_WO) + (size_t)l * DM * DM), DstPlain{0}, I8_SW, tb);
        else if (l >= F8_WOUT_FROM) cvt_matrix_f8(F, F.inp(I_WOUT) + (size_t)l * DM * DM, DM, DM, DM, (unsigned char*)((bf16*)(F.ws + WS_WO) + (size_t)l * DM * DM), DstPlain{0}, F8_SW, tb);
        else cvt_matrix(F, F.inp(I_WOUT) + (size_t)l * DM * DM, DM, DM, DM, (bf16*)(F.ws + WS_WO) + (size_t)l * DM * DM, DstPlain{0}, tb);
    }
    for (int i = 0; i < 2; ++i) {
        const size_t so = (size_t)i * DM * DFF;
        bf16* gu = (bf16*)(F.ws + WS_FGU) + (size_t)i * 2 * DFF * DM;
        if (I8_UP && (i != 0 || I8_UP_L0)) {
            cvt_matrix_i8(F, F.inp(I_FWG) + so, DFF, DFF, DM, (unsigned char*)gu, DstGU{0}, I8_SW, tb);
            cvt_matrix_i8(F, F.inp(I_FWU) + so, DFF, DFF, DM, (unsigned char*)gu, DstGU{1}, I8_SW, tb);
            if (2 * i == F8_DENSE_LAYER) cvt_matrix_f8(F, F.inp(I_FWD) + so, DM, DM, DFF, (unsigned char*)((bf16*)(F.ws + WS_FD) + (size_t)i * DM * DFF), DstPlain{0}, F8_SW, tb);
            else cvt_matrix(F, F.inp(I_FWD) + so, DM, DM, DFF, (bf16*)(F.ws + WS_FD) + (size_t)i * DM * DFF, DstPlain{0}, tb);
        } else if (2 * i == F8_DENSE_LAYER) {
            cvt_matrix_f8(F, F.inp(I_FWG) + so, DFF, DFF, DM, (unsigned char*)gu, DstGU{0}, F8_SW, tb);
            cvt_matrix_f8(F, F.inp(I_FWU) + so, DFF, DFF, DM, (unsigned char*)gu, DstGU{1}, F8_SW, tb);
            cvt_matrix_f8(F, F.inp(I_FWD) + so, DM, DM, DFF, (unsigned char*)((bf16*)(F.ws + WS_FD) + (size_t)i * DM * DFF), DstPlain{0}, F8_SW, tb);
        } else {
        const float* fg = F.inp(I_FFNG) + (2 * i) * DM;
        cvt_matrix(F, F.inp(I_FWG) + so, DFF, DFF, DM, gu, DstGU{0}, tb, fg);
        cvt_matrix(F, F.inp(I_FWU) + so, DFF, DFF, DM, gu, DstGU{1}, tb, fg);
        cvt_matrix(F, F.inp(I_FWD) + so, DM, DM, DFF, (bf16*)(F.ws + WS_FD) + (size_t)i * DM * DFF, DstPlain{0}, tb);
        }
    }
    cvt_moe_layer(F, 0, tb, 0, NEXP);
    cvt_moe_layer(F, 1, tb, F.G > TAIL_WG0 ? MOE1_TAIL_EXPERTS : 0, NEXP);
    { const float* s = F.inp(I_SWS); bf16* d = (bf16*)(F.ws + WS_SGUW); const int n4 = DEPTH * 4 * 128 * 128 / 4;
      for (int i = blockIdx.x * 512 + F.tid; i < n4; i += F.G * 512) { const f32x4 v = *(const f32x4*)(s + (size_t)i * 4); u32x2 w; w.x = cvt_pk_bf16(v[0], v[1]); w.y = cvt_pk_bf16(v[2], v[3]); *(u32x2*)(d + (size_t)i * 4) = w; } }
}

__device__ __forceinline__ void hinit_phase(const Frame& F, const float* src, bf16* hb, unsigned char* x8, const float* gain) {
    const int lane = F.lane, rows_per_wg = NTOK / F.G, rpw = rows_per_wg / 8;
    float* part = (float*)(F.ws + WS_PART);
    const size_t tb = (size_t)blockIdx.x * rows_per_wg + (size_t)F.wave * rpw;
    f32x4 g8v[4];
#pragma unroll
    for (int i = 0; i < 4; ++i) g8v[i] = x8 ? *(const f32x4*)(gain + i * 256 + lane * 4) * (I8_WIN ? I8_SXN : F8_SX) : (f32x4){0.f, 0.f, 0.f, 0.f};
    for (int r0 = 0; r0 < rpw; r0 += 4) {
        f32x4 v[4][4];
#pragma unroll
        for (int r = 0; r < 4; ++r)
#pragma unroll
            for (int i = 0; i < 4; ++i) v[r][i] = *(const f32x4*)(src + (tb + r0 + r) * DM + i * 256 + lane * 4);
#pragma unroll
        for (int r = 0; r < 4; ++r) { const size_t t = tb + r0 + r; float ss = 0.f;
#pragma unroll
            for (int i = 0; i < 4; ++i) { const f32x4 x = v[r][i]; ss += (x[0] * x[0] + x[1] * x[1]) + (x[2] * x[2] + x[3] * x[3]);
                u32x2 w; w.x = cvt_pk_bf16(x[0], x[1]); w.y = cvt_pk_bf16(x[2], x[3]); *(u32x2*)(hb + t * DM + i * 256 + lane * 4) = w;
                if (x8) { const f32x4 xs_ = x * g8v[i]; *(unsigned*)(x8 + t * DM + i * 256 + lane * 4) = I8_WIN ? cvt4_i8(xs_[0], xs_[1], xs_[2], xs_[3]) : cvt4_fp8(xs_[0], xs_[1], xs_[2], xs_[3]); } }
            ss = wave_sum(ss);
            if (lane < 16) part[t * 16 + lane] = lane == 0 ? ss : 0.f; }
    }
}
template <bool FINAL>
__device__ __forceinline__ void combine_norm_phase(const Frame& F, bf16* h, const float* gain, unsigned char* xf8, float* outf) {
    const int lane = F.lane, rows_per_wg = NTOK / F.G, rpw = rows_per_wg / 8;
    const unsigned* route = (const unsigned*)(F.ws + WS_ROUTE);
    const bf16* y = (const bf16*)(F.ws + WS_Y);
    f32x4 gv[4];
#pragma unroll
    for (int i = 0; i < 4; ++i) gv[i] = *(const f32x4*)(gain + i * 256 + lane * 4);
    const size_t tb = (size_t)blockIdx.x * rows_per_wg + (size_t)F.wave * rpw;
    u32x4 rr = (u32x4){0u, 0u, 0u, 0u};
    if (lane < rpw) rr = *(const u32x4*)(route + (tb + lane) * 8 + 4);
    u32x2 hc[4], ya[4], yb[4];
    { const size_t s0 = (unsigned)__builtin_amdgcn_readlane((int)rr.z, 0), s1 = (unsigned)__builtin_amdgcn_readlane((int)rr.w, 0);
#pragma unroll
      for (int i = 0; i < 4; ++i) { hc[i] = *(const u32x2*)(h + tb * DM + i * 256 + lane * 4); ya[i] = *(const u32x2*)(y + s0 * DM + i * 256 + lane * 4); yb[i] = *(const u32x2*)(y + s1 * DM + i * 256 + lane * 4); } }
    for (int ri = 0; ri < rpw; ++ri) {
        const size_t t = tb + ri;
        u32x2 hn[4], na[4], nb[4];
        { const int rn = ri + 1 < rpw ? ri + 1 : ri;
          const size_t s0 = (unsigned)__builtin_amdgcn_readlane((int)rr.z, rn), s1 = (unsigned)__builtin_amdgcn_readlane((int)rr.w, rn);
#pragma unroll
          for (int i = 0; i < 4; ++i) { hn[i] = *(const u32x2*)(h + (tb + rn) * DM + i * 256 + lane * 4); na[i] = *(const u32x2*)(y + s0 * DM + i * 256 + lane * 4); nb[i] = *(const u32x2*)(y + s1 * DM + i * 256 + lane * 4); } }
        const float w0 = __uint_as_float((unsigned)__builtin_amdgcn_readlane((int)rr.x, ri)), w1 = __uint_as_float((unsigned)__builtin_amdgcn_readlane((int)rr.y, ri));
        f32x4 v[4];
#pragma unroll
        for (int i = 0; i < 4; ++i) {
            v[i][0] = bflo(hc[i].x) + (w0 * bflo(ya[i].x) + w1 * bflo(yb[i].x)); v[i][1] = bfhi(hc[i].x) + (w0 * bfhi(ya[i].x) + w1 * bfhi(yb[i].x));
            v[i][2] = bflo(hc[i].y) + (w0 * bflo(ya[i].y) + w1 * bflo(yb[i].y)); v[i][3] = bfhi(hc[i].y) + (w0 * bfhi(ya[i].y) + w1 * bfhi(yb[i].y)); }
        if (!FINAL) {
#pragma unroll
            for (int i = 0; i < 4; ++i) { u32x2 w; w.x = cvt_pk_bf16(v[i][0], v[i][1]); w.y = cvt_pk_bf16(v[i][2], v[i][3]); *(u32x2*)(h + t * DM + i * 256 + lane * 4) = w; }
        }
        float ss = 0.f;
#pragma unroll
        for (int i = 0; i < 4; ++i) ss += (v[i][0] * v[i][0] + v[i][1] * v[i][1]) + (v[i][2] * v[i][2] + v[i][3] * v[i][3]);
        ss = wave_sum(ss);
        const float rstd = __builtin_amdgcn_rsqf(ss * (1.0f / DM) + EPS);
#pragma unroll
        for (int i = 0; i < 4; ++i) v[i] = v[i] * rstd * gv[i];
        if (FINAL) {
#pragma unroll
            for (int i = 0; i < 4; ++i) *(f32x4*)(outf + t * DM + i * 256 + lane * 4) = v[i];
        } else {
#pragma unroll
            for (int i = 0; i < 4; ++i) *(unsigned*)(xf8 + t * DM + i * 256 + lane * 4) = I8_WIN ? cvt4_i8(v[i][0] * I8_SXN, v[i][1] * I8_SXN, v[i][2] * I8_SXN, v[i][3] * I8_SXN)
                                                                                                 : cvt4_fp8(v[i][0] * F8_SX, v[i][1] * F8_SX, v[i][2] * F8_SX, v[i][3] * F8_SX);
        }
#pragma unroll
        for (int i = 0; i < 4; ++i) { hc[i] = hn[i]; ya[i] = na[i]; yb[i] = nb[i]; }
    }
}
constexpr unsigned SLOT_MAIN = 65536u;
template <int MODE>
__device__ __forceinline__ void combine_final_rows(const Frame& F, const bf16* h, const float* gain, float* outf, size_t row0, int nrows) {
    const int lane = F.lane;
    if (nrows <= 0) return;
    const unsigned* route = (const unsigned*)(F.ws + WS_ROUTE);
    const bf16* y = (const bf16*)(F.ws + WS_Y);
    f32x4 gv[4];
#pragma unroll
    for (int i = 0; i < 4; ++i) gv[i] = *(const f32x4*)(gain + i * 256 + lane * 4);
    u32x4 rr = (u32x4){0u, 0u, 0u, 0u};
    if (lane < nrows) rr = *(const u32x4*)(route + (row0 + lane) * 8 + 4);
    u32x2 hc[4], ya[4], yb[4];
    if (MODE == 1) { const size_t s0 = (unsigned)__builtin_amdgcn_readlane((int)rr.z, 0), s1 = (unsigned)__builtin_amdgcn_readlane((int)rr.w, 0);
#pragma unroll
      for (int i = 0; i < 4; ++i) { hc[i] = *(const u32x2*)(h + row0 * DM + i * 256 + lane * 4); ya[i] = *(const u32x2*)(y + s0 * DM + i * 256 + lane * 4); yb[i] = *(const u32x2*)(y + s1 * DM + i * 256 + lane * 4); } }
    for (int ri = 0; ri < nrows; ++ri) {
        const size_t t = row0 + ri;
        const unsigned c0 = (unsigned)__builtin_amdgcn_readlane((int)rr.z, ri), c1 = (unsigned)__builtin_amdgcn_readlane((int)rr.w, ri);
        const bool ready = (c0 < SLOT_MAIN) && (c1 < SLOT_MAIN);
        u32x2 hn[4], na[4], nb[4];
        if (MODE == 1) { const int rn = ri + 1 < nrows ? ri + 1 : ri;
          const size_t s0 = (unsigned)__builtin_amdgcn_readlane((int)rr.z, rn), s1 = (unsigned)__builtin_amdgcn_readlane((int)rr.w, rn);
#pragma unroll
          for (int i = 0; i < 4; ++i) { hn[i] = *(const u32x2*)(h + (row0 + rn) * DM + i * 256 + lane * 4); na[i] = *(const u32x2*)(y + s0 * DM + i * 256 + lane * 4); nb[i] = *(const u32x2*)(y + s1 * DM + i * 256 + lane * 4); } }
        else if (!ready) {
#pragma unroll
          for (int i = 0; i < 4; ++i) { hc[i] = *(const u32x2*)(h + t * DM + i * 256 + lane * 4); ya[i] = *(const u32x2*)(y + (size_t)c0 * DM + i * 256 + lane * 4); yb[i] = *(const u32x2*)(y + (size_t)c1 * DM + i * 256 + lane * 4); } }
        if ((MODE == 1) == ready) {
            const float w0 = __uint_as_float((unsigned)__builtin_amdgcn_readlane((int)rr.x, ri)), w1 = __uint_as_float((unsigned)__builtin_amdgcn_readlane((int)rr.y, ri));
            f32x4 v[4];
#pragma unroll
            for (int i = 0; i < 4; ++i) {
                v[i][0] = bflo(hc[i].x) + (w0 * bflo(ya[i].x) + w1 * bflo(yb[i].x)); v[i][1] = bfhi(hc[i].x) + (w0 * bfhi(ya[i].x) + w1 * bfhi(yb[i].x));
                v[i][2] = bflo(hc[i].y) + (w0 * bflo(ya[i].y) + w1 * bflo(yb[i].y)); v[i][3] = bfhi(hc[i].y) + (w0 * bfhi(ya[i].y) + w1 * bfhi(yb[i].y)); }
            float ss = 0.f;
#pragma unroll
            for (int i = 0; i < 4; ++i) ss += (v[i][0] * v[i][0] + v[i][1] * v[i][1]) + (v[i][2] * v[i][2] + v[i][3] * v[i][3]);
            ss = wave_sum(ss);
            const float rstd = __builtin_amdgcn_rsqf(ss * (1.0f / DM) + EPS);
#pragma unroll
            for (int i = 0; i < 4; ++i) *(f32x4*)(outf + t * DM + i * 256 + lane * 4) = v[i] * rstd * gv[i];
        }
        if (MODE == 1) {
#pragma unroll
            for (int i = 0; i < 4; ++i) { hc[i] = hn[i]; ya[i] = na[i]; yb[i] = nb[i]; } }
    }
}
__device__ __forceinline__ void route_permute_phase(const Frame& F, const bf16* src, const float* gain, int moe_idx) {
    const int lane = F.lane, rows_per_wg = NTOK / F.G, rpw = rows_per_wg / 8;
    unsigned* route = (unsigned*)(F.ws + WS_ROUTE);
    unsigned char* xs = F.ws + WS_Y;
    LAS unsigned char* R8 = (LAS unsigned char*)F.lds;
    LAS int* lcnt = (LAS int*)(F.lds + 131072);
    LAS unsigned* ltmp = (LAS unsigned*)(F.lds + 131072 + 128);
    LAS unsigned* ltab = (LAS unsigned*)(F.lds + 131072 + 4096);
    unsigned* tab = F.ctl + CW_TAB + moe_idx * 2048; unsigned* arr = F.ctl + CW_ARR + moe_idx * 64;
    f32x4 gv[4];
#pragma unroll
    for (int i = 0; i < 4; ++i) gv[i] = *(const f32x4*)(gain + i * 256 + lane * 4);
    f32x4 rw[16][2];
    { const float* R = F.inp(I_ROUTER) + (size_t)moe_idx * DM * NEXP;
#pragma unroll
      for (int i = 0; i < 4; ++i)
#pragma unroll
        for (int j = 0; j < 4; ++j) { const int k = i * 256 + lane * 4 + j; rw[i * 4 + j][0] = *(const f32x4*)(R + k * 8); rw[i * 4 + j][1] = *(const f32x4*)(R + k * 8 + 4); } }
    if (F.tid < 32) lcnt[F.tid] = 0;
    __syncthreads();
    u32x2 pc[4];
#pragma unroll
    for (int i = 0; i < 4; ++i) pc[i] = *(const u32x2*)(src + ((size_t)blockIdx.x * rows_per_wg + F.wave * rpw) * DM + i * 256 + lane * 4);
    for (int ri = 0; ri < rpw; ++ri) {
        const int lr = F.wave * rpw + ri;
        const size_t t = (size_t)blockIdx.x * rows_per_wg + lr;
        u32x2 pn[4];
        { const size_t tn = t + (ri + 1 < rpw ? 1 : 0);
#pragma unroll
          for (int i = 0; i < 4; ++i) pn[i] = *(const u32x2*)(src + tn * DM + i * 256 + lane * 4); }
        f32x4 v[4];
#pragma unroll
        for (int i = 0; i < 4; ++i) v[i] = (f32x4){bflo(pc[i].x), bfhi(pc[i].x), bflo(pc[i].y), bfhi(pc[i].y)};
        float ss = 0.f;
#pragma unroll
        for (int i = 0; i < 4; ++i) ss += (v[i][0] * v[i][0] + v[i][1] * v[i][1]) + (v[i][2] * v[i][2] + v[i][3] * v[i][3]);
        ss = wave_sum(ss);
        const float rstd = __builtin_amdgcn_rsqf(ss * (1.0f / DM) + EPS);
#pragma unroll
        for (int i = 0; i < 4; ++i) { v[i] = v[i] * rstd * gv[i];
            *(LAS unsigned*)(R8 + lr * 1024 + i * 256 + lane * 4) = I8_UP ? cvt4_i8(v[i][0] * I8_SXN, v[i][1] * I8_SXN, v[i][2] * I8_SXN, v[i][3] * I8_SXN) : cvt4_fp8(v[i][0] * F8_SX, v[i][1] * F8_SX, v[i][2] * F8_SX, v[i][3] * F8_SX); }
#pragma unroll
        for (int i = 0; i < 4; ++i) pc[i] = pn[i];
        float lg[8];
#pragma unroll
        for (int e = 0; e < 8; ++e) lg[e] = 0.f;
#pragma unroll
        for (int i = 0; i < 4; ++i)
#pragma unroll
            for (int j = 0; j < 4; ++j) { const float x = v[i][j];
#pragma unroll
                for (int e = 0; e < 4; ++e) { lg[e] += x * rw[i * 4 + j][0][e]; lg[4 + e] += x * rw[i * 4 + j][1][e]; } }
#pragma unroll
        for (int e = 0; e < 8; ++e) lg[e] = wave_sum(lg[e]);
        int e0 = 0; float v0 = lg[0];
#pragma unroll
        for (int e = 1; e < 8; ++e) if (lg[e] > v0) { v0 = lg[e]; e0 = e; }
        int e1 = -1; float v1 = -3.0e38f;
#pragma unroll
        for (int e = 0; e < 8; ++e) if (e != e0 && lg[e] > v1) { v1 = lg[e]; e1 = e; }
        const float ex = __expf(v1 - v0), w0 = __builtin_amdgcn_rcpf(1.0f + ex), w1 = ex * w0;
        if (lane == 0) {
            const int p0 = __hip_atomic_fetch_add(&lcnt[e0], 1, __ATOMIC_RELAXED, __HIP_MEMORY_SCOPE_WORKGROUP), p1 = __hip_atomic_fetch_add(&lcnt[e1], 1, __ATOMIC_RELAXED, __HIP_MEMORY_SCOPE_WORKGROUP);
            LAS unsigned* q = ltmp + lr * 6; q[0] = (unsigned)e0; q[1] = (unsigned)e1; q[2] = (unsigned)p0; q[3] = (unsigned)p1; q[4] = __float_as_uint(w0); q[5] = __float_as_uint(w1);
        }
    }
    __syncthreads();
    if (F.wave == 0) {
        if (lane < 8) { __hip_atomic_store(tab + blockIdx.x * 8 + lane, (unsigned)lcnt[lane], __ATOMIC_RELAXED, __HIP_MEMORY_SCOPE_AGENT);
                        (void)__hip_atomic_fetch_add(F.ctl + CW_CNT + moe_idx * 64 + lane, (unsigned)lcnt[lane], __ATOMIC_RELAXED, __HIP_MEMORY_SCOPE_AGENT); }
        asm volatile("s_waitcnt vmcnt(0)" ::: "memory");
        if (lane == 0) (void)__hip_atomic_fetch_add(arr, 1u, __ATOMIC_RELAXED, __HIP_MEMORY_SCOPE_AGENT);
        unsigned sp = 0;
        while ((unsigned)__builtin_amdgcn_readfirstlane((int)__hip_atomic_load(arr, __ATOMIC_RELAXED, __HIP_MEMORY_SCOPE_AGENT)) < (unsigned)F.G) { __builtin_amdgcn_s_sleep(2); if (++sp > (1u << 22)) break; }
        __builtin_amdgcn_fence(__ATOMIC_ACQUIRE, "agent");
        asm volatile("s_waitcnt vmcnt(0)" ::: "memory");
    }
    __syncthreads();
    for (int i = F.tid; i < F.G * 8; i += 512) ltab[i] = __hip_atomic_load(tab + i, __ATOMIC_RELAXED, __HIP_MEMORY_SCOPE_AGENT);
    __syncthreads();
    if (F.tid < 8) { int tot = 0, base = 0;
        for (int w = 0; w < F.G; ++w) { const int c = (int)ltab[w * 8 + F.tid]; base += (w < (int)blockIdx.x) ? c : 0; tot += c; }
        lcnt[8 + F.tid] = base; lcnt[24 + F.tid] = tot; }
    __syncthreads();
    if (F.tid == 0) { int sacc = 0;
#pragma unroll
        for (int e = 0; e < 8; ++e) { lcnt[16 + e] = sacc; sacc += (lcnt[24 + e] + 255) >> 8; } }
    __syncthreads();
    for (int ri = 0; ri < rpw; ++ri) {
        const int lr = F.wave * rpw + ri;
        const size_t t = (size_t)blockIdx.x * rows_per_wg + lr;
        const LAS unsigned* q = ltmp + lr * 6;
        const unsigned e0 = q[0], e1 = q[1];
        const size_t s0 = (size_t)lcnt[16 + e0] * 256 + (size_t)lcnt[8 + e0] + q[2], s1 = (size_t)lcnt[16 + e1] * 256 + (size_t)lcnt[8 + e1] + q[3];
        const u32x4 o = *(const LAS u32x4*)(R8 + lr * 1024 + lane * 16);
        *(u32x4*)(xs + s0 * DM + lane * 16) = o; *(u32x4*)(xs + s1 * DM + lane * 16) = o;
        if (lane == 0) { u32x4 r0; r0.x = e0; r0.y = e1; r0.z = q[2]; r0.w = q[3]; u32x4 r1; r1.x = q[4]; r1.y = q[5]; r1.z = (unsigned)s0; r1.w = (unsigned)s1;
            *(u32x4*)(route + t * 8) = r0; *(u32x4*)(route + t * 8 + 4) = r1; }
    }
    __syncthreads();
}
__device__ __forceinline__ void moe_tile_prefix(const Frame& F, int moe_idx, int (&tp)[9]) {
    int s = 0;
#pragma unroll
    for (int e = 0; e < 8; ++e) { tp[e] = s; const unsigned c = (unsigned)__builtin_amdgcn_readfirstlane((int)__hip_atomic_load(F.ctl + CW_CNT + moe_idx * 64 + e, __ATOMIC_RELAXED, __HIP_MEMORY_SCOPE_AGENT)); s += (int)((c + 255u) >> 8); }
    tp[8] = s;
}
__device__ __forceinline__ void conv_phase(const Frame& F, int layer, int f8out) {
    bf16* a = (bf16*)(F.ws + WS_BIG);
    LAS unsigned* L = (LAS unsigned*)F.lds;
    const float* dww = F.inp(I_DWW) + (size_t)layer * 31 * 512; const float* dwb = F.inp(I_DWB) + layer * 512;
    const float* lng = F.inp(I_CLNG) + layer * 512; const float* lnb = F.inp(I_CLNB) + layer * 512;
    const int cp = F.tid & 255, th = F.tid >> 8;
    f32x2 w[31];
#pragma unroll
    for (int k = 0; k < 31; ++k) w[k] = *(const f32x2*)(dww + k * 512 + cp * 2);
    const f32x2 bias = *(const f32x2*)(dwb + cp * 2);
    for (int u = blockIdx.x; u < NTOK / 64; u += F.G) {
        const int t0 = u * 64, pos0 = t0 & (SEQ - 1);
        { u32x4 o[12];
#pragma unroll
          for (int i = 0; i < 12; ++i) { const int id = F.tid + i * 512, j = id >> 6, ch = (id & 63) * 8; o[i] = (u32x4){0u, 0u, 0u, 0u};
              if (id < 94 * 64 && pos0 - 30 + j >= 0) o[i] = *(const u32x4*)(a + (size_t)(t0 - 30 + j) * LDA + A_CONV + ch); }
#pragma unroll
          for (int i = 0; i < 12; ++i) { const int id = F.tid + i * 512, j = id >> 6, ch = (id & 63) * 8;
              if (id < 94 * 64) *(LAS u32x4*)(L + j * 256 + (ch >> 1)) = o[i]; } }
        __syncthreads();
        f32x2 acc[4][8];
#pragma unroll
        for (int tb = 0; tb < 4; ++tb) {
            f32x2 x[38];
#pragma unroll
            for (int j = 0; j < 38; ++j) { const unsigned p = L[(th * 32 + tb * 8 + j) * 256 + cp]; x[j] = (f32x2){bflo(p), bfhi(p)}; }
#pragma unroll
            for (int i = 0; i < 8; ++i) { f32x2 s = bias;
#pragma unroll
                for (int k = 0; k < 31; ++k) s += x[i + k] * w[k];
                acc[tb][i] = s; }
        }
        __syncthreads();
#pragma unroll
        for (int tb = 0; tb < 4; ++tb)
#pragma unroll
            for (int i = 0; i < 8; ++i) L[(th * 32 + tb * 8 + i) * 256 + cp] = cvt_pk_bf16(acc[tb][i].x, acc[tb][i].y);
        __syncthreads();
        {
            const int c0 = F.lane * 8;
            const f32x4 g0 = *(const f32x4*)(lng + c0), g1 = *(const f32x4*)(lng + c0 + 4), b0 = *(const f32x4*)(lnb + c0), b1 = *(const f32x4*)(lnb + c0 + 4);
            for (int i = 0; i < 8; ++i) {
                const int tl = F.wave * 8 + i;
                const u32x4 p = *(const LAS u32x4*)(L + tl * 256 + F.lane * 4);
                float x[8] = {bflo(p.x), bfhi(p.x), bflo(p.y), bfhi(p.y), bflo(p.z), bfhi(p.z), bflo(p.w), bfhi(p.w)};
                float s = 0.f;
#pragma unroll
                for (int j = 0; j < 8; ++j) s += x[j];
                const float mu = wave_sum(s) * (1.0f / 512.0f);
                float q = 0.f;
#pragma unroll
                for (int j = 0; j < 8; ++j) { x[j] -= mu; q += x[j] * x[j]; }
                const float rstd = __builtin_amdgcn_rsqf(wave_sum(q) * (1.0f / 512.0f) + EPS);
                float yv[8];
#pragma unroll
                for (int j = 0; j < 8; ++j) { const float gg = j < 4 ? g0[j] : g1[j - 4], bb = j < 4 ? b0[j] : b1[j - 4]; const float yy = x[j] * rstd * gg + bb; yv[j] = yy * fast_sigmoid(yy); }
                if (f8out) { u32x2 o8; o8.x = cvt4_fp8(yv[0] * F8_SX, yv[1] * F8_SX, yv[2] * F8_SX, yv[3] * F8_SX); o8.y = cvt4_fp8(yv[4] * F8_SX, yv[5] * F8_SX, yv[6] * F8_SX, yv[7] * F8_SX);
                    *(u32x2*)((unsigned char*)a + (size_t)(t0 + tl) * (LDA * 2) + A8_HC + c0) = o8; }
                else {
                u32x4 o; o.x = cvt_pk_bf16(yv[0], yv[1]); o.y = cvt_pk_bf16(yv[2], yv[3]); o.z = cvt_pk_bf16(yv[4], yv[5]); o.w = cvt_pk_bf16(yv[6], yv[7]);
                *(u32x4*)(a + (size_t)(t0 + tl) * LDA + A_HC + c0) = o; }
            }
        }
        __syncthreads();
    }
}

__device__ __forceinline__ void sgu_phase(const Frame& F, int layer, int ocol, int f8out) {
    bf16* a = (bf16*)(F.ws + WS_BIG);
    constexpr int VP = 520;
    LAS bf16* V = (LAS bf16*)F.lds;
    const bf16* W = (const bf16*)(F.ws + WS_SGUW) + (size_t)layer * 4 * 128 * 128;
    const float* bs = F.inp(I_SBS) + layer * 4 * 128;
    const float* lng = F.inp(I_SLNG) + layer * 512; const float* lnb = F.inp(I_SLNB) + layer * 512;
    const int lane = F.lane, fr = lane & 15, fq = lane >> 4;
    for (int u = blockIdx.x; u < NTOK / 128; u += F.G) {
        const size_t t0 = (size_t)u * 128;
        {
            const int c0 = lane * 8;
            const f32x4 g0 = *(const f32x4*)(lng + c0), g1 = *(const f32x4*)(lng + c0 + 4), b0 = *(const f32x4*)(lnb + c0), b1 = *(const f32x4*)(lnb + c0 + 4);
            u32x4 pv[16];
#pragma unroll
            for (int i = 0; i < 16; ++i) pv[i] = *(const u32x4*)(a + (t0 + F.wave * 16 + i) * LDA + A_SGU + 512 + c0);
#pragma unroll
            for (int i = 0; i < 16; ++i) {
                const int s = F.wave * 16 + i;
                const u32x4 p = pv[i];
                float x[8] = {bflo(p.x), bfhi(p.x), bflo(p.y), bfhi(p.y), bflo(p.z), bfhi(p.z), bflo(p.w), bfhi(p.w)};
                float sm = 0.f;
#pragma unroll
                for (int j = 0; j < 8; ++j) sm += x[j];
                const float mu = wave_sum(sm) * (1.0f / 512.0f);
                float q = 0.f;
#pragma unroll
                for (int j = 0; j < 8; ++j) { x[j] -= mu; q += x[j] * x[j]; }
                const float rstd = __builtin_amdgcn_rsqf(wave_sum(q) * (1.0f / 512.0f) + EPS);
                float yv[8];
#pragma unroll
                for (int j = 0; j < 8; ++j) { const float gg = j < 4 ? g0[j] : g1[j - 4], bb = j < 4 ? b0[j] : b1[j - 4]; yv[j] = x[j] * rstd * gg + bb; }
                u32x4 o; o.x = cvt_pk_bf16(yv[0], yv[1]); o.y = cvt_pk_bf16(yv[2], yv[3]); o.z = cvt_pk_bf16(yv[4], yv[5]); o.w = cvt_pk_bf16(yv[6], yv[7]);
                *(LAS u32x4*)(V + s * VP + c0) = o;
            }
        }
        __syncthreads();
        {
            const int g = F.wave >> 1, cb = g * 128 + (F.wave & 1) * 64;
            const bf16* Wg = W + (size_t)g * 128 * 128;
            f32x4 acc[8][4];
#pragma unroll
            for (int m = 0; m < 8; ++m)
#pragma unroll
                for (int n = 0; n < 4; ++n) acc[m][n] = (f32x4){0.f, 0.f, 0.f, 0.f};
#pragma unroll 1
            for (int ks = 0; ks < 4; ++ks) {
                bf16x8 bfr[4];
#pragma unroll
                for (int n = 0; n < 4; ++n) {
                    const LAS bf16* vp = V + (ks * 32 + fq * 8) * VP + cb + n * 16 + fr;
#pragma unroll
                    for (int j = 0; j < 8; ++j) bfr[n][j] = (short)vp[j * VP];
                }
#pragma unroll
                for (int m = 0; m < 8; ++m) {
                    if (ks >= 2 && m < 4) continue;
                    const bf16x8 afr = *(const bf16x8*)(Wg + (m * 16 + fr) * 128 + ks * 32 + fq * 8);
#pragma unroll
                    for (int n = 0; n < 4; ++n) acc[m][n] = __builtin_amdgcn_mfma_f32_16x16x32_bf16(bfr[n], afr, acc[m][n], 0, 0, 0);
                }
            }
#pragma unroll
            for (int mh = 0; mh < 2; ++mh) {
            u32x2 uq[4][4]; float bq[4];
#pragma unroll
            for (int mm = 0; mm < 4; ++mm) { const int t = (mh * 4 + mm) * 16 + fr; bq[mm] = bs[g * 128 + t];
                const bf16* rp = a + (t0 + t) * LDA + A_SGU + cb + 4 * fq;
#pragma unroll
                for (int n = 0; n < 4; ++n) uq[mm][n] = *(const u32x2*)(rp + n * 16); }
#pragma unroll
            for (int mm = 0; mm < 4; ++mm) { const int m = mh * 4 + mm;
                const int t = m * 16 + fr; const float bb = bq[mm];
                bf16* wp = a + (t0 + t) * LDA + ocol + cb + 4 * fq;
                unsigned char* wp8 = (unsigned char*)a + (t0 + t) * (size_t)(LDA * 2) + A8_SGU + cb + 4 * fq;
#pragma unroll
                for (int n = 0; n < 4; ++n) { const u32x2 uu = uq[mm][n]; const f32x4 v = acc[m][n];
                    const float h0 = bflo(uu.x) * (v[0] + bb), h1 = bfhi(uu.x) * (v[1] + bb), h2 = bflo(uu.y) * (v[2] + bb), h3 = bfhi(uu.y) * (v[3] + bb);
                    if (f8out) *(unsigned*)(wp8 + n * 16) = cvt4_fp8(h0 * F8_SX, h1 * F8_SX, h2 * F8_SX, h3 * F8_SX);
                    else { u32x2 o; o.x = cvt_pk_bf16(h0, h1); o.y = cvt_pk_bf16(h2, h3); *(u32x2*)(wp + n * 16) = o; } }
            }
            }
        }
        __syncthreads();
    }
}

template <class Sched>
__device__ __forceinline__ pg8::RowScale build_row_scale(const Frame& F, const Sched& S, bool by_pn) {
    pg8::RowScale R; LAS float* tab = (LAS float*)(F.lds + LDS_ROWSCALE_OFF); const float* part = (const float*)(F.ws + WS_PART);
    R.tab = tab; R.part = part; R.p0 = -1; R.p1 = -1; R.p2 = -1; R.p3 = -1; int ns = 0;
    pg8::Unit u;
    for (int i = 0; S.next(i, u); ++i) {
        const int p = by_pn ? u.pn : u.pm;
        if (p == R.p0 || p == R.p1 || p == R.p2 || p == R.p3 || ns >= 4) continue;
        if (ns == 0) R.p0 = p; else if (ns == 1) R.p1 = p; else if (ns == 2) R.p2 = p; else R.p3 = p;
        ++ns;
    }
    {
        const int hs = F.tid >> 8, rw = F.tid & 255;
        const int pa = hs ? R.p1 : R.p0, pb = hs ? R.p3 : R.p2;
        f32x4 qa[4], qb[4];
#pragma unroll
        for (int k = 0; k < 4; ++k) { qa[k] = (f32x4){0.f, 0.f, 0.f, 0.f}; qb[k] = (f32x4){0.f, 0.f, 0.f, 0.f}; }
        if (pa >= 0) { const float* pp = part + (size_t)(pa * 256 + rw) * 16;
#pragma unroll
            for (int k = 0; k < 4; ++k) qa[k] = *(const f32x4*)(pp + 4 * k); }
        if (pb >= 0) { const float* pp = part + (size_t)(pb * 256 + rw) * 16;
#pragma unroll
            for (int k = 0; k < 4; ++k) qb[k] = *(const f32x4*)(pp + 4 * k); }
        if (pa >= 0) { const float sm = (((qa[0][0] + qa[0][1]) + (qa[0][2] + qa[0][3])) + ((qa[1][0] + qa[1][1]) + (qa[1][2] + qa[1][3]))) + (((qa[2][0] + qa[2][1]) + (qa[2][2] + qa[2][3])) + ((qa[3][0] + qa[3][1]) + (qa[3][2] + qa[3][3])));
            tab[hs * 256 + rw] = __builtin_amdgcn_rsqf(sm * (1.0f / DM) + EPS); }
        if (pb >= 0) { const float sm = (((qb[0][0] + qb[0][1]) + (qb[0][2] + qb[0][3])) + ((qb[1][0] + qb[1][1]) + (qb[1][2] + qb[1][3]))) + (((qb[2][0] + qb[2][1]) + (qb[2][2] + qb[2][3])) + ((qb[3][0] + qb[3][1]) + (qb[3][2] + qb[3][3])));
            tab[(2 + hs) * 256 + rw] = __builtin_amdgcn_rsqf(sm * (1.0f / DM) + EPS); }
    }
    __syncthreads();
    return R;
}
__device__ __forceinline__ pg8::RowScale no_row_scale() { pg8::RowScale R; R.tab = nullptr; R.part = nullptr; R.p0 = -1; R.p1 = -1; R.p2 = -1; R.p3 = -1; return R; }

constexpr int PH_PER_LAYER = 9;
constexpr int N_PHASES = 1 + DEPTH * PH_PER_LAYER;

__global__ void __launch_bounds__(512, 2) trunk_fwd(Args args) {
    extern __shared__ __attribute__((aligned(16))) unsigned char lds_raw[];
    Frame F;
    F.lds = (LAS unsigned char*)lds_raw;
    F.out = args.out; F.ws = args.ws; F.ctl = (unsigned*)(args.ws + WS_CTL);
    F.rethread(); F.G = gridDim.x; F.cvG = F.G; F.cvId = (int)blockIdx.x;
    volatile LAS unsigned* MISC = (volatile LAS unsigned*)(F.lds + LDSCTL_OFF);
    if (F.tid < 64) MISC[F.tid] = 0u;
    if (F.tid == 0) {
#pragma unroll
        for (int i = 0; i < 26; ++i) *(LAS unsigned long long*)(F.lds + LDSCTL_OFF + 256 + 8 * i) = (unsigned long long)args.in[i]; }
    __syncthreads();
#if MK_MULTI
#define GRID_BAR() do { } while (0)
#else
    XcdBarrier bar = xcd_barrier_post(F.ctl + CW_BAR, MISC + 8);
#define GRID_BAR() do { XcdBarrier b_; b_.bar = (unsigned*)F.ws + CW_BAR; b_.x = xb_xcc_id(); b_.st = MISC + 8; xcd_barrier(b_); } while (0)
#endif
#if MK_MULTI
    const int lo = args.ph_lo, hi = args.ph_hi;
#else
    constexpr int lo = 0, hi = N_PHASES;
#endif
#define IN(k) (lo <= (k) && (k) < hi)
#define SEAM(k) do { if (IN(k) && IN((k) + 1)) GRID_BAR(); } while (0)

#define a     ((bf16*)(F.ws + WS_BIG))
#define hb    ((bf16*)(F.ws + WS_XN))
#define xf8   (F.ws + WS_XF8)
#define partb ((float*)(F.ws + WS_PART))
#define inter ((bf16*)(F.ws + WS_BIG))
#define ybuf  ((bf16*)(F.ws + WS_Y))

    if (IN(0)) {
        F.rethread();
#pragma unroll 1
        for (int rep = (PROBE & 1) ? 0 : 1; rep < 2; ++rep) { if (PHM(0)) prologue_convert(F); }
        if (PHM(1)) hinit_phase(F, F.inp(I_X), hb, F8_GATE_FROM == 0 ? xf8 : nullptr, F.inp(I_MIXG));
    }
    SEAM(0);

    for (int layer = 0; layer < DEPTH; ++layer) {
        const int pb = 1 + layer * PH_PER_LAYER;
        const bool moe = (layer & 1) != 0; const int fi = layer >> 1;

        if (IN(pb + 0)) {
#pragma unroll 1
          for (int rep = (PROBE & 16) ? 0 : 1; rep < 2; ++rep) {
            F.rethread();
            if (PHM(2) && layer >= F8_GATE_FROM && layer < F8_WIN_FROM && !I8_WIN_ALL) {
              LAS float* lb = (LAS float*)(F.lds + LDS_BIAS_OFF); const float* bg = F.inp(I_BGATE) + layer * 3 * DM;
              { pg8::SchedWin S; S.o.init(NTOK / 256, 14, F.G, (int)blockIdx.x); S.A = (const char*)hb; S.B = (const char*)(F.ws + WS_WIN) + (size_t)layer * NMAIN * DM * 2; S.tA = 256 * DM * 2; S.tB = 256 * DM * 2; S.nlo = 12; S.skip = 12; S.boff = 0;
                const pg8::RowScale RS = build_row_scale(F, S, false);
                pg8::EpiWin E{a, bg, lb, 1.0f, F.ws + WS_G8, RS};
                pg8::gemm_phase(F.lds, DM, DM * 2, DM * 2, S, E); }
              { F.rethread();
                pg8::SchedWin S; S.o.init(NTOK / 256, 12, F.G, (int)blockIdx.x); S.A = (const char*)xf8; S.B = (const char*)(F.ws + WS_WG8 + (size_t)layer * WS_WG8_STEP); S.tA = 256 * DM; S.tB = 256 * DM; S.nlo = 0; S.skip = 12; S.boff = 12;
                float bl[6];
#pragma unroll
                for (int k = 0; k < 6; ++k) bl[k] = bg[F.tid + k * 512];
                const pg8::RowScale RS = build_row_scale(F, S, false);
#pragma unroll
                for (int k = 0; k < 6; ++k) lb[F.tid + k * 512] = bl[k];
                __syncthreads();
                if (I8_WIN) { pg8::EpiWin E{a, bg, lb, 1.0f / (((layer & 1) ? i8_sxu(layer - 1) : I8_SXN) * I8_SW), F.ws + WS_G8, RS};
                    pg8::gemm_phase<pg8::EpiWin, pg8::SchedWin, false, true>(F.lds, DM / 2, DM, DM, S, E); }
                else { pg8::EpiWin E{a, bg, lb, 1.0f / (F8_SX * F8_SW), F.ws + WS_G8, RS};
                pg8::gemm_phase<pg8::EpiWin, pg8::SchedWin, true>(F.lds, DM / 2, DM, DM, S, E); } }
            } else
            if (PHM(2)) { pg8::SchedPlain S; S.o.init(NTOK / 256, NMAIN / 256, F.G, (int)blockIdx.x); S.A = (layer >= F8_WIN_FROM || I8_WIN_ALL) ? (const char*)xf8 : (const char*)hb; S.B = (const char*)(F.ws + WS_WIN) + (size_t)layer * NMAIN * DM * 2; S.tA = 256 * DM * 2; S.tB = 256 * DM * 2;
              LAS float* lb = (LAS float*)(F.lds + LDS_BIAS_OFF); const float* bg = F.inp(I_BGATE) + layer * 3 * DM;
              float bl[6];
#pragma unroll
              for (int k = 0; k < 6; ++k) bl[k] = bg[F.tid + k * 512];
              const pg8::RowScale RS = (moe || layer == 0) ? build_row_scale(F, S, false) : no_row_scale();
#pragma unroll
              for (int k = 0; k < 6; ++k) lb[F.tid + k * 512] = bl[k];
              __syncthreads();
              if (layer >= F8_WIN_FROM || I8_WIN_ALL) { S.tA = 256 * DM; S.tB = 256 * DM;
                  if (I8_WIN) { pg8::EpiWin E{a, bg, lb, 1.0f / (((layer & 1) ? i8_sxu(layer - 1) : I8_SXN) * I8_SW), F.ws + WS_G8, RS};
                      pg8::gemm_phase<pg8::EpiWin, pg8::SchedPlain, false, true>(F.lds, DM / 2, DM, DM, S, E); }
                  else { pg8::EpiWin E{a, bg, lb, 1.0f / (F8_SX * F8_SW), F.ws + WS_G8, RS};
                  pg8::gemm_phase<pg8::EpiWin, pg8::SchedPlain, true>(F.lds, DM / 2, DM, DM, S, E); }
              } else {
              pg8::EpiWin E{a, bg, lb, 1.0f, F.ws + WS_G8, RS};
              pg8::gemm_phase(F.lds, DM, DM * 2, DM * 2, S, E); } }
          }
        }
        SEAM(pb + 0);
        if (IN(pb + 1)) {
            const bool attn_first = (((int)blockIdx.x >> 3) & 1) != 0;
#pragma unroll 1
            for (int slot = 0; slot < 2; ++slot) {
              if ((slot == 0) == attn_first) { F.rethread(); if (PHM(6)) {
                LAS float* tab = (LAS float*)(F.lds + ATTN_TAB_OFF);
                { const float* rb = F.inp(I_RELB) + (size_t)layer * 8 * 192;
                  for (int i = F.tid; i < 8 * 192; i += 512) tab[i] = (rb[i] - rb[(i / 192) * 192 + 191]) * LOG2E; }
                asm volatile("s_waitcnt vmcnt(0)" ::: "memory");
                __syncthreads();
                const fa::AttnTensors AT{(const fa::bf16*)(a + A_Q), (const fa::bf16*)(a + A_K), (const fa::bf16*)(a + A_V), (fa::bf16*)(a + A_Q), (layer >= F8_BR_FROM) ? (unsigned char*)a + A8_ATT : nullptr};
                const int vcu = ((int)blockIdx.x % 8) * (F.G / 8) + (int)blockIdx.x / 8;
                fa::attn_phase<8>((char*)F.lds, AT, vcu, F.G, tab);
                __syncthreads(); } }
              else {
#pragma unroll 1
                for (int rep = (PROBE & 4) ? 0 : 1; rep < 2; ++rep) { F.rethread(); if (PHM(5)) sgu_phase(F, layer, rep == 0 ? A_CONV + 512 : A_SGU, (layer >= F8_BR_FROM) ? 1 : 0); }
#pragma unroll 1
                for (int rep = (PROBE & 2) ? 0 : 1; rep < 2; ++rep) { F.rethread(); if (PHM(4)) conv_phase(F, layer, (layer >= F8_BR_FROM) ? 1 : 0); } }
            } }
        SEAM(pb + 1);
        if (IN(pb + 2) && PHM(7)) {
            F.rethread();
            pg8::SchedBranch S; S.o.init(NTOK / 256, DM / 256, F.G, (int)blockIdx.x); S.abase = (const char*)a; S.W = (const char*)(F.ws + WS_WBR) + (size_t)layer * 3 * DM * 512 * 2; S.f8 = 0;
            if (layer >= F8_BR_FROM) { S.f8 = 1;
                pg8::EpiBranch E{a, F.ws + WS_G8, layer >= I8_WOUT_FROM ? 2 : 1, (layer >= I8_WOUT_FROM ? I8_SXM / F8_SX : 1.0f) / (F8_SW * 256.0f)};
                pg8::gemm_phase<pg8::EpiBranch, pg8::SchedBranch, true>(F.lds, 512 / 2, LDA * 2, 512, S, E);
            } else {
            pg8::EpiBranch E{a, F.ws + WS_G8, layer >= I8_WOUT_FROM ? 2 : (layer >= F8_WOUT_FROM ? 1 : 0), layer >= I8_WOUT_FROM ? I8_SXM : F8_SX};
            pg8::gemm_phase(F.lds, 512, LDA * 2, 512 * 2, S, E); }
        }
        SEAM(pb + 2);
        if (IN(pb + 3) && PHM(8)) {
            F.rethread();
            pg8::SchedPlain S; S.o.init(NTOK / 256, DM / 256, F.G, (int)blockIdx.x); S.A = (const char*)(a + A_G); S.B = (const char*)(F.ws + WS_WO) + (size_t)layer * DM * DM * 2; S.tA = 256 * (size_t)LDA * 2; S.tB = 256 * DM * 2;
            if (layer >= I8_WOUT_FROM) { S.tB = 256 * DM;
                pg8::EpiRes E{hb, xf8, F.inp(I_FFNG) + layer * DM, partb, 1.0f / (I8_SXM * I8_SW), (I8_UP && (layer != 0 || I8_UP_L0)) ? (moe ? 0 : 2) : ((layer == F8_DENSE_LAYER) ? 1 : 0), moe ? 0 : 1, i8_sxu(layer)};
                pg8::gemm_phase<pg8::EpiRes, pg8::SchedPlain, false, true>(F.lds, DM / 2, LDA * 2, DM, S, E);
            } else if (layer >= F8_WOUT_FROM) { S.tB = 256 * DM;
                pg8::EpiRes E{hb, xf8, F.inp(I_FFNG) + layer * DM, partb, 1.0f / (F8_SX * F8_SW), (I8_UP && (layer != 0 || I8_UP_L0)) ? (moe ? 0 : 2) : ((layer == F8_DENSE_LAYER) ? 1 : 0), moe ? 0 : 1, i8_sxu(layer)};
                pg8::gemm_phase<pg8::EpiRes, pg8::SchedPlain, true>(F.lds, DM / 2, LDA * 2, DM, S, E);
            } else {
            pg8::EpiRes E{hb, xf8, F.inp(I_FFNG) + layer * DM, partb, 1.0f, (I8_UP && (layer != 0 || I8_UP_L0)) ? (moe ? 0 : 2) : ((layer == F8_DENSE_LAYER) ? 1 : 0), moe ? 0 : 1, i8_sxu(layer)};
            pg8::gemm_phase(F.lds, DM, LDA * 2, DM * 2, S, E); }
        }
        SEAM(pb + 3);
        if (IN(pb + 4)) {
            F.rethread();
            if (moe) { if (PHM(9)) route_permute_phase(F, hb, F.inp(I_FFNG) + layer * DM, fi); }
        }
        if (moe) SEAM(pb + 4);
        if (IN(pb + 6)) {
#pragma unroll 1
          for (int rep = ((PROBE & 32) && !moe) || ((PROBE & 64) && moe) ? 0 : 1; rep < 2; ++rep) {
            F.rethread();
            if (!moe) { if (PHM(11)) {
                pg8::SchedPlain S; S.o.init(NTOK / 256, 2 * DFF / 256, F.G, (int)blockIdx.x); S.A = ((I8_UP && (layer != 0 || I8_UP_L0)) || layer == F8_DENSE_LAYER) ? (const char*)xf8 : (const char*)hb; S.B = (const char*)(F.ws + WS_FGU) + (size_t)fi * 2 * DFF * DM * 2; S.tA = 256 * DM * 2; S.tB = 256 * DM * 2;
                const pg8::RowScale RS = build_row_scale(F, S, false);
                if (I8_UP && (layer != 0 || I8_UP_L0)) { S.tA = 256 * DM; S.tB = 256 * DM;
                    if (layer == F8_DENSE_LAYER) { pg8::EpiSwigluF8 E{(unsigned char*)inter, DFF, 1.0f / (i8_sxu(layer) * I8_SW), F8_SI, RS};
                        pg8::gemm_phase<pg8::EpiSwigluF8, pg8::SchedPlain, false, true>(F.lds, DM / 2, DM, DM, S, E); }
                    else { pg8::EpiSwiglu E{inter, DFF, RS, 1.0f / (i8_sxu(layer) * I8_SW)};
                        pg8::gemm_phase<pg8::EpiSwiglu, pg8::SchedPlain, false, true>(F.lds, DM / 2, DM, DM, S, E); }
                } else if (layer == F8_DENSE_LAYER) { S.tA = 256 * DM; S.tB = 256 * DM;
                    pg8::EpiSwigluF8 E{(unsigned char*)inter, DFF, 1.0f / (F8_SX * F8_SW), F8_SI, RS};
                    pg8::gemm_phase<pg8::EpiSwigluF8, pg8::SchedPlain, true>(F.lds, DM / 2, DM, DM, S, E);
                } else {
                pg8::EpiSwiglu E{inter, DFF, RS, 1.0f};
                pg8::gemm_phase(F.lds, DM, DM * 2, DM * 2, S, E); } }
            } else if (PHM(12)) {
                int tp[9]; moe_tile_prefix(F, fi, tp);
                pg8::SchedMoe S; S.o.init(tp[8], 2 * DFE / 256, F.G, (int)blockIdx.x); S.A = (const char*)ybuf; S.B = (const char*)(F.ws + WS_MGU) + (size_t)fi * NEXP * 2 * DFE * DM; S.tA = 256 * DM; S.tB = 256 * DM; S.bexp = (size_t)2 * DFE * DM;
                S.tp1 = tp[1]; S.tp2 = tp[2]; S.tp3 = tp[3]; S.tp4 = tp[4]; S.tp5 = tp[5]; S.tp6 = tp[6]; S.tp7 = tp[7];
                if (I8_UP) { pg8::EpiSwigluF8 E{(unsigned char*)inter, DFE, 1.0f / (I8_SXN * I8_SW), F8_SI, no_row_scale()};
                    pg8::gemm_phase<pg8::EpiSwigluF8, pg8::SchedMoe, false, true>(F.lds, DM / 2, DM, DM, S, E); }
                else { pg8::EpiSwigluF8 E{(unsigned char*)inter, DFE, 1.0f / (F8_SX * F8_SW), F8_SI, no_row_scale()};
                pg8::gemm_phase<pg8::EpiSwigluF8, pg8::SchedMoe, true>(F.lds, DM / 2, DM, DM, S, E); }
            }
          }
        }
        SEAM(pb + 6);
        if (IN(pb + 7)) {
#pragma unroll 1
          for (int rep = ((PROBE & 128) && moe) ? 0 : 1; rep < 2; ++rep) {
            F.rethread();
            if (!moe) { if (PHM(13)) {
                pg8::SchedPlain S; S.o.init(NTOK / 256, DM / 256, F.G, (int)blockIdx.x); S.A = (const char*)inter; S.B = (const char*)(F.ws + WS_FD) + (size_t)fi * DM * DFF * 2; S.tA = 256 * (size_t)DFF * 2; S.tB = 256 * (size_t)DFF * 2;
                if (layer == F8_DENSE_LAYER) { S.tA = 256 * (size_t)DFF; S.tB = 256 * (size_t)DFF;
                    pg8::EpiRes E{hb, xf8, F.inp(I_MIXG) + (layer + 1) * DM, partb, 1.0f / (F8_SI * F8_SW), (layer + 1 >= F8_GATE_FROM) ? (I8_WIN ? 2 : 1) : 0, 1, i8_sxu(layer)};
                    pg8::gemm_phase<pg8::EpiRes, pg8::SchedPlain, true>(F.lds, DFF / 2, DFF, DFF, S, E);
                } else {
                pg8::EpiRes E{hb, xf8, F.inp(I_MIXG) + (layer + 1) * DM, partb, 1.0f, (layer + 1 >= F8_GATE_FROM) ? (I8_WIN ? 2 : 1) : 0, 1, i8_sxu(layer)};
                pg8::gemm_phase(F.lds, DFF, DFF * 2, DFF * 2, S, E); } }
            } else if (PHM(14)) {
                int tp[9]; moe_tile_prefix(F, fi, tp);
                const bool split = SPLIT_FINAL && layer == DEPTH - 1 && F.G == 256 && !(PROBE & 128);
                pg8::SchedMoe S; S.o.init(split ? 256 : tp[8], DM / 256, F.G, (int)blockIdx.x); S.A = (const char*)inter; S.B = (const char*)(F.ws + WS_MD) + (size_t)fi * NEXP * DM * DFE; S.tA = 256 * (size_t)DFE; S.tB = 256 * (size_t)DFE; S.bexp = (size_t)DM * DFE;
                S.tp1 = tp[1]; S.tp2 = tp[2]; S.tp3 = tp[3]; S.tp4 = tp[4]; S.tp5 = tp[5]; S.tp6 = tp[6]; S.tp7 = tp[7];
                pg8::EpiBf16Plain E{ybuf, DM, 1.0f / (F8_SI * F8_SW), no_row_scale()};
                pg8::gemm_phase<pg8::EpiBf16Plain, pg8::SchedMoe, true>(F.lds, DFE / 2, DFE, DFE, S, E);
                if (split) {
                    unsigned* cnt = F.ctl + CW_P7A;
                    asm volatile("s_waitcnt vmcnt(0)" ::: "memory"); __syncthreads();
                    if (F.tid == 0) { __builtin_amdgcn_fence(__ATOMIC_RELEASE, "agent"); asm volatile("s_waitcnt vmcnt(0)" ::: "memory"); (void)__hip_atomic_fetch_add(cnt, 1u, __ATOMIC_RELAXED, __HIP_MEMORY_SCOPE_AGENT); }
                    const int ntail = (tp[8] - 256) * 4 > 0 ? (tp[8] - 256) * 4 : 0;
                    if ((int)blockIdx.x < ntail) {
                        pg8::SchedTail T; T.m = S; T.pm = 256 + ((int)blockIdx.x >> 2); T.pn = (int)blockIdx.x & 3;
                        pg8::gemm_phase<pg8::EpiBf16Plain, pg8::SchedTail, true>(F.lds, DFE / 2, DFE, DFE, T, E);
                    } else {
                        if (F.wave == 0) { unsigned sp = 0;
                            while ((unsigned)__builtin_amdgcn_readfirstlane((int)__hip_atomic_load(cnt, __ATOMIC_RELAXED, __HIP_MEMORY_SCOPE_AGENT)) < (unsigned)F.G) { __builtin_amdgcn_s_sleep(2); if (++sp > (1u << 22)) break; }
                            __builtin_amdgcn_fence(__ATOMIC_ACQUIRE, "agent"); asm volatile("s_waitcnt vmcnt(0)" ::: "memory"); }
                        __syncthreads();
                        F.rethread();
                        const int nfree = F.G - ntail, j = (int)blockIdx.x - ntail;
                        int Rw = (NTOK + nfree - 1) / nfree; Rw = (Rw + 7) & ~7; const int rpwv = Rw >> 3;
                        const long r0 = (long)j * Rw + (long)F.wave * rpwv; long nr = (long)NTOK - r0; if (nr > rpwv) nr = rpwv;
                        combine_final_rows<1>(F, hb, F.inp(I_FING), F.out, (size_t)r0, (int)nr);
                    }
                }
                if (layer == 1 && (int)blockIdx.x >= TAIL_WG0 && F.G > TAIL_WG0) {
                    F.rethread(); Frame F2 = F; F2.cvG = F.G - TAIL_WG0; F2.cvId = (int)blockIdx.x - TAIL_WG0; int tb2 = 0;
                    cvt_moe_layer(F2, 1, tb2, 0, MOE1_TAIL_EXPERTS); }
            }
          }
        }
        SEAM(pb + 7);
        if (IN(pb + 8)) {
            F.rethread();
            const float* gnext = (layer == DEPTH - 1) ? F.inp(I_FING) : F.inp(I_MIXG) + (layer + 1) * DM;
            if (moe) { if (PHM(15)) {
                if (layer == DEPTH - 1) { if (SPLIT_FINAL && F.G == 256 && !(PROBE & 128)) combine_final_rows<2>(F, hb, gnext, F.out, (size_t)blockIdx.x * (NTOK / 256) + (size_t)F.wave * 16, 16);
                                          else combine_norm_phase<true>(F, hb, gnext, nullptr, F.out); }
                else combine_norm_phase<false>(F, hb, gnext, xf8, nullptr); } }
        }
        if (moe && layer != DEPTH - 1) SEAM(pb + 8);
    }
#undef IN
#undef SEAM
#undef GRID_BAR
#undef a
#undef hb
#undef xf8
#undef partb
#undef inter
#undef ybuf
}

extern "C" void kernel_launch(void* const* d_in, const int* in_sizes, int n_in, void* d_out, int out_size, void* d_ws, size_t ws_size, hipStream_t stream) {
    static int grid = 0;
    if (grid == 0) {
        if (n_in != 26 || in_sizes[0] != NTOK * DM || out_size != NTOK * DM || ws_size < WS_END) { fprintf(stderr, "kernel_launch: unexpected shapes / workspace (n_in %d, ws %zu, need %zu)\n", n_in, ws_size, (size_t)WS_END); grid = -1; return; }
        int dev = 0, cus = 0, per_cu = 0;
        if (hipGetDevice(&dev) != hipSuccess || hipDeviceGetAttribute(&cus, hipDeviceAttributeMultiprocessorCount, dev) != hipSuccess) { grid = -1; return; }
        if (hipFuncSetAttribute((const void*)trunk_fwd, hipFuncAttributeMaxDynamicSharedMemorySize, LDS_BYTES) != hipSuccess) { fprintf(stderr, "kernel_launch: hipFuncSetAttribute failed\n"); grid = -1; return; }
        if (hipOccupancyMaxActiveBlocksPerMultiprocessor(&per_cu, (const void*)trunk_fwd, 512, LDS_BYTES) != hipSuccess || per_cu < 1) { fprintf(stderr, "kernel_launch: occupancy query reports %d\n", per_cu); }
        (void)hipGetLastError();
        grid = cus;
        if (grid > 256) grid = 256;
    }
    if (grid < 0) return;
    if (hipMemsetAsync((char*)d_ws + WS_CTL, 0, CTL_ZERO_BYTES, stream) != hipSuccess) return;
    Args a{};
    for (int i = 0; i < 26; ++i) a.in[i] = (const float*)d_in[i];
    a.out = (float*)d_out; a.ws = (unsigned char*)d_ws;
#if MK_MULTI
    for (int p = 0; p < N_PHASES; ++p) { a.ph_lo = p; a.ph_hi = p + 1; hipLaunchKernelGGL(trunk_fwd, dim3(grid), dim3(512), LDS_BYTES, stream, a); }
#else
    a.ph_lo = 0; a.ph_hi = N_PHASES;
    hipLaunchKernelGGL(trunk_fwd, dim3(grid), dim3(512), LDS_BYTES, stream, a);
#endif
}
```
